# Optimizing an MI355X kernel written in HIP

```python
import jax, jax.numpy as jnp
from jax import lax
import numpy as np

D_MODEL = 1024
BATCH = 4
SEQ = 8192
DEPTH = 4

HEAD_DIM = 64
A_Q_HEADS = 8
A_KV_HEADS = 2
B_GROUP_CFG = ((128, 1), (512, 4), (2048, 16))
B_HEADS_PER_GROUP = 4
B_GROUPS = len(B_GROUP_CFG)
B_HEADS = B_GROUPS * B_HEADS_PER_GROUP
POOL_WINDOWS = (2, 4, 8, 16)
POOL_GROUPS = len(POOL_WINDOWS)
POOL_GROUP_WIDTH = 128
POOL_WIDTH = POOL_GROUPS * POOL_GROUP_WIDTH
N_BRANCHES = 3
D_FF = ((-(-8 * D_MODEL // 3) + 255) // 256) * 256
GRID_W = 64
ROPE_THETA = 10000.0
BLOCK = 128
EPS = 1e-6
NEG_INF = -1e30

A_Q_WIDTH = A_Q_HEADS * HEAD_DIM
A_KV_WIDTH = A_KV_HEADS * HEAD_DIM
B_WIDTH = B_HEADS * HEAD_DIM
B_OUT_WIDTH = B_HEADS_PER_GROUP * HEAD_DIM
GATE_WIDTH = N_BRANCHES * D_MODEL
IN_WIDTH = A_Q_WIDTH + 2 * A_KV_WIDTH + 3 * B_WIDTH + POOL_WIDTH + GATE_WIDTH
SPLIT_POINTS = (
    A_Q_WIDTH,
    A_Q_WIDTH + A_KV_WIDTH,
    A_Q_WIDTH + 2 * A_KV_WIDTH,
    A_Q_WIDTH + 2 * A_KV_WIDTH + B_WIDTH,
    A_Q_WIDTH + 2 * A_KV_WIDTH + 2 * B_WIDTH,
    A_Q_WIDTH + 2 * A_KV_WIDTH + 3 * B_WIDTH,
    A_Q_WIDTH + 2 * A_KV_WIDTH + 3 * B_WIDTH + POOL_WIDTH,
)
RESID_SCALE = (2 * DEPTH) ** -0.5

kernel_name = 'hybrid_gated_axial_dilated_pool_encoder'


def rms_norm(x, g):
    xf = x.astype(jnp.float32)
    y = xf * lax.rsqrt(jnp.mean(xf * xf, axis=-1, keepdims=True) + EPS)
    return (y * g.astype(jnp.float32)).astype(x.dtype)


def rope_angles(pos, dim):
    inv = ROPE_THETA ** (-jnp.arange(0, dim, 2, dtype=jnp.float32) / dim)
    return pos.astype(jnp.float32)[:, None] * inv[None, :]


def apply_rope(x, ang):
    xf = x.astype(jnp.float32)
    x1, x2 = jnp.split(xf, 2, axis=-1)
    c = jnp.cos(ang)[None, :, None, :]
    s = jnp.sin(ang)[None, :, None, :]
    return jnp.concatenate([x1 * c - x2 * s, x2 * c + x1 * s], axis=-1).astype(x.dtype)


def apply_axial_rope(x, ang_row, ang_col):
    xr, xc = jnp.split(x, 2, axis=-1)
    return jnp.concatenate([apply_rope(xr, ang_row), apply_rope(xc, ang_col)], axis=-1)


def dense_gqa_blocked(q, k, v):
    b, s, hq, dh = q.shape
    hkv = k.shape[2]
    g = hq // hkv
    nb = s // BLOCK
    scale = dh ** -0.5
    qb = q.reshape(b, nb, BLOCK, hkv, g, dh).transpose(1, 0, 2, 3, 4, 5)

    def one_block(q_blk):
        sc = jnp.einsum('bqkgd,bskd->bkgqs', q_blk, k, preferred_element_type=jnp.float32) * scale
        p = jax.nn.softmax(sc, axis=-1)
        return jnp.einsum('bkgqs,bskd->bqkgd', p.astype(v.dtype), v)

    o = lax.map(one_block, qb)
    return o.transpose(1, 0, 2, 3, 4, 5).reshape(b, s, hq * dh)


def dilated_window_attention(q, k, v, dilation, half_span):
    b, s, h, dh = q.shape
    L = s // dilation
    nb = -(-L // BLOCK)
    lp = nb * BLOCK
    bd = b * dilation

    def to_sub(t):
        t = t.reshape(b, L, dilation, h, dh).transpose(0, 2, 1, 3, 4).reshape(bd, L, h, dh)
        return jnp.pad(t, ((0, 0), (0, lp - L), (0, 0), (0, 0)))

    def band(t):
        tp = jnp.pad(t, ((0, 0), (BLOCK, BLOCK), (0, 0), (0, 0)))
        return jnp.concatenate(
            [tp[:, i * BLOCK:i * BLOCK + lp].reshape(bd, nb, BLOCK, h, dh) for i in range(3)], axis=2)

    qb = to_sub(q).reshape(bd, nb, BLOCK, h, dh)
    kb = band(to_sub(k))
    vb = band(to_sub(v))
    sc = jnp.einsum('znqhd,znkhd->znhqk', qb, kb, preferred_element_type=jnp.float32) * (dh ** -0.5)
    blk = jnp.arange(nb)[:, None, None] * BLOCK
    qpos = blk + jnp.arange(BLOCK)[None, :, None]
    kpos = blk - BLOCK + jnp.arange(3 * BLOCK)[None, None, :]
    valid = (jnp.abs(qpos - kpos) <= half_span) & (kpos >= 0) & (kpos < L)
    sc = jnp.where(valid[None, :, None], sc, NEG_INF)
    m = jnp.max(sc, axis=-1, keepdims=True)
    p = jnp.exp(sc - m)
    den = jnp.sum(p, axis=-1, keepdims=True)
    o = jnp.einsum('znhqk,znkhd->znqhd', (p / den).astype(v.dtype), vb)
    lse = (m + jnp.log(den))[..., 0]
    o = o.reshape(b, dilation, lp, h, dh)[:, :, :L].transpose(0, 2, 1, 3, 4).reshape(b, s, h, dh)
    lse = lse.transpose(0, 1, 3, 2).reshape(b, dilation, lp, h)[:, :, :L]
    lse = lse.transpose(0, 2, 1, 3).reshape(b, s, h)
    return o, lse


def multiscale_pool(u, lin, scale):
    b, s, _ = u.shape
    uf = u.astype(jnp.float32).reshape(b, s, POOL_GROUPS, POOL_GROUP_WIDTH)
    cs = jnp.pad(lax.cumsum(uf, axis=1), ((0, 0), (1, 0), (0, 0), (0, 0)))
    t = jnp.arange(s)
    outs = []
    for gi, w in enumerate(POOL_WINDOWS):
        lo = jnp.clip(t - w // 2, 0, s)
        hi = jnp.clip(t + w - w // 2, 0, s)
        mean = (cs[:, hi, gi] - cs[:, lo, gi]) / (hi - lo).astype(jnp.float32)[None, :, None]
        outs.append(mean - uf[:, :, gi])
    pooled = jnp.stack(outs, axis=2).astype(u.dtype)
    mixed = jnp.einsum('bsgc,gcd->bsgd', pooled, lin)
    return mixed.reshape(b, s, POOL_WIDTH) * scale


def setup_inputs(seed: int = 0) -> dict:
    key = jax.random.key(seed)
    ks = jax.random.split(key, 19)
    f32 = jnp.float32

    def nrm(k, shape, fan_in):
        return jax.random.normal(k, shape, f32) * (fan_in ** -0.5)

    def gain(k, shape):
        return 1.0 + 0.02 * jax.random.normal(k, shape, f32)

    return {
        'x': jax.random.normal(ks[0], (BATCH, SEQ, D_MODEL), f32),
        'norm_mix': gain(ks[1], (DEPTH, D_MODEL)),
        'w_in': nrm(ks[2], (DEPTH, D_MODEL, IN_WIDTH), D_MODEL),
        'b_gate': 0.02 * jax.random.normal(ks[3], (DEPTH, GATE_WIDTH), f32),
        'qn_a': gain(ks[4], (DEPTH, HEAD_DIM)),
        'kn_a': gain(ks[5], (DEPTH, HEAD_DIM)),
        'qn_b': gain(ks[6], (DEPTH, HEAD_DIM)),
        'kn_b': gain(ks[7], (DEPTH, HEAD_DIM)),
        'pool_lin': nrm(ks[8], (DEPTH, POOL_GROUPS, POOL_GROUP_WIDTH, POOL_GROUP_WIDTH), POOL_GROUP_WIDTH),
        'pool_scale': gain(ks[9], (DEPTH, POOL_WIDTH)),
        'w_branch_a': nrm(ks[10], (DEPTH, A_Q_WIDTH, D_MODEL), A_Q_WIDTH),
        'w_branch_b': nrm(ks[11], (DEPTH, B_OUT_WIDTH, D_MODEL), B_OUT_WIDTH),
        'w_branch_c': nrm(ks[12], (DEPTH, POOL_WIDTH, D_MODEL), POOL_WIDTH),
        'w_out': nrm(ks[13], (DEPTH, D_MODEL, D_MODEL), D_MODEL) * RESID_SCALE,
        'norm_ffn': gain(ks[14], (DEPTH, D_MODEL)),
        'w_ffn_gate': nrm(ks[15], (DEPTH, D_MODEL, D_FF), D_MODEL),
        'w_ffn_up': nrm(ks[16], (DEPTH, D_MODEL, D_FF), D_MODEL),
        'w_ffn_down': nrm(ks[17], (DEPTH, D_FF, D_MODEL), D_FF) * RESID_SCALE,
    }


def reference(x, norm_mix, w_in, b_gate, qn_a, kn_a, qn_b, kn_b, pool_lin, pool_scale,
              w_branch_a, w_branch_b, w_branch_c, w_out, norm_ffn, w_ffn_gate, w_ffn_up, w_ffn_down):
    b, s, _ = x.shape
    rows = s // GRID_W
    row_idx = jnp.repeat(jnp.arange(rows), GRID_W)
    col_idx = jnp.tile(jnp.arange(GRID_W), rows)
    ang_row = rope_angles(row_idx, HEAD_DIM // 2)
    ang_col = rope_angles(col_idx, HEAD_DIM // 2)
    ang_seq = rope_angles(jnp.arange(s), HEAD_DIM)

    for l in range(DEPTH):
        h = rms_norm(x, norm_mix[l])
        z = h @ w_in[l]
        qa, ka, va, qb, kb, vb, uc, gz = jnp.split(z, SPLIT_POINTS, axis=-1)

        qa = apply_axial_rope(rms_norm(qa.reshape(b, s, A_Q_HEADS, HEAD_DIM), qn_a[l]), ang_row, ang_col)
        ka = apply_axial_rope(rms_norm(ka.reshape(b, s, A_KV_HEADS, HEAD_DIM), kn_a[l]), ang_row, ang_col)
        va = va.reshape(b, s, A_KV_HEADS, HEAD_DIM)
        ya = dense_gqa_blocked(qa, ka, va) @ w_branch_a[l]

        qb = apply_rope(rms_norm(qb.reshape(b, s, B_HEADS, HEAD_DIM), qn_b[l]), ang_seq)
        kb = apply_rope(rms_norm(kb.reshape(b, s, B_HEADS, HEAD_DIM), kn_b[l]), ang_seq)
        qb = qb.reshape(b, s, B_GROUPS, B_HEADS_PER_GROUP, HEAD_DIM)
        kb = kb.reshape(b, s, B_GROUPS, B_HEADS_PER_GROUP, HEAD_DIM)
        vb = vb.reshape(b, s, B_GROUPS, B_HEADS_PER_GROUP, HEAD_DIM)
        o_list, lse_list = [], []
        for gi, (window, dil) in enumerate(B_GROUP_CFG):
            o_g, lse_g = dilated_window_attention(qb[:, :, gi], kb[:, :, gi], vb[:, :, gi], dil, window // (2 * dil))
            o_list.append(o_g)
            lse_list.append(lse_g)
        wts = jax.nn.softmax(jnp.stack(lse_list, axis=0), axis=0)
        ob = jnp.einsum('gbsh,gbshd->bshd', wts.astype(x.dtype), jnp.stack(o_list, axis=0))
        yb = ob.reshape(b, s, B_OUT_WIDTH) @ w_branch_b[l]

        yc = multiscale_pool(uc, pool_lin[l], pool_scale[l]) @ w_branch_c[l]

        gates = jax.nn.sigmoid(gz + b_gate[l]).reshape(b, s, N_BRANCHES, D_MODEL)
        merged = gates[:, :, 0] * ya + gates[:, :, 1] * yb + gates[:, :, 2] * yc
        x = x + merged @ w_out[l]

        h2 = rms_norm(x, norm_ffn[l])
        x = x + (jax.nn.silu(h2 @ w_ffn_gate[l]) * (h2 @ w_ffn_up[l])) @ w_ffn_down[l]
    return x
```

```cpp
#include <hip/hip_runtime.h>
#include <hip/hip_cooperative_groups.h>
#include <cstdio>
#include <cstdint>
namespace cg = cooperative_groups;
namespace pg8 {
#define PG8_LAS __attribute__((address_space(3)))
typedef unsigned short bf16_t;
typedef short bf16x8 __attribute__((ext_vector_type(8)));
typedef float f32x4 __attribute__((ext_vector_type(4)));
typedef unsigned u32x4 __attribute__((ext_vector_type(4)));
constexpr int BM = 256, BK = 64, HALF = 128, HTB = HALF * BK * 2  , STAGE_BYTES = 8 * HTB, NXCD = 8, WGM = 8;

__host__ __device__ __forceinline__ int lds_byte(int r, int c) { const int st = (r >> 4) * 2 + (c >> 5), rr = r & 15, cc = c & 31, ob = rr * 64 + cc * 2; return st * 1024 + (ob ^ (((ob >> 9) & 1) << 5)); }
__host__ __device__ __forceinline__ void stage_rc(int b, int& R, int& C) { const int st = b / 1024, sb = b % 1024, swz = sb ^ (((sb >> 9) & 1) << 5); R = (st >> 1) * 16 + swz / 64; C = (st & 1) * 32 + (swz % 64) / 2; }
__host__ __device__ __forceinline__ int perm32(int rho) { const int n = rho >> 4, i = rho & 15; return 8 * (i >> 2) + 4 * n + (i & 3); }

struct Unit { int pm, pn; };
struct Gemm { const bf16_t* A; const bf16_t* Bt; int M, N, K; };

struct StaticOrder {
    int nM, nN, nwg, G, c;
    __host__ __device__ void init(int M, int N, int G_, int c_) { nM = M / BM; nN = N / BM; nwg = nM * nN; G = G_; c = c_; }
    __host__ __device__ bool next(int i, Unit& u) const {
        const long L = (long)i * G + c; if (L >= nwg) return false;
        int wgid = (int)L; { const int q = nwg / NXCD, r = nwg % NXCD, xcd = wgid % NXCD, off = wgid / NXCD; wgid = (xcd < r ? xcd * (q + 1) : r * (q + 1) + (xcd - r) * q) + off; }
        const int nig = WGM * nN, gid = wgid / nig, fm = gid * WGM, gsz = (nM - fm) < WGM ? (nM - fm) : WGM;
        u.pm = fm + ((wgid % nig) % gsz); u.pn = (wgid % nig) / gsz; return true;
    }
    __device__ __forceinline__ void a_ready(const Unit&) const {}
    __device__ __forceinline__ void done(const Unit&) const {}
};

typedef float f32x2c __attribute__((ext_vector_type(2))); typedef __bf16 bf16x2c __attribute__((ext_vector_type(2)));
__device__ __forceinline__ unsigned cvt_pk_bf16(float lo, float hi) { f32x2c v = {lo, hi}; bf16x2c b = __builtin_convertvector(v, bf16x2c); return __builtin_bit_cast(unsigned, b); }
typedef float f32x2 __attribute__((ext_vector_type(2)));
template <class Epi, class Sched, bool ALIGN_EPI = false, bool SP2 = false>
__device__ __forceinline__ void gemm_phase(PG8_LAS unsigned char* lds, const Gemm g, const Sched& S, const Epi& E) {
    int tid_raw = threadIdx.x; asm volatile("" : "+v"(tid_raw));
    const int tid = tid_raw, wid = __builtin_amdgcn_readfirstlane(tid >> 6), lane = tid & 63, wr = wid >> 2, wc = wid & 3, fr = lane & 15, fq = lane >> 4;
    const int K = g.K, nt = K / BK;
    unsigned voffA[2], voffB[2];
#pragma unroll
    for (int i = 0; i < 2; ++i) { int R, C; stage_rc(tid * 16 + i * 8192, R, C); const int Rb = Epi::PERM ? ((R & ~31) + perm32(R & 31)) : R;
        voffA[i] = (unsigned)(R * K + C) * 2u; voffB[i] = (unsigned)(Rb * K + C) * 2u; }
    const size_t kstep = (size_t)(BK * 2);
    const size_t hstep = (size_t)HALF * K * 2;
    const size_t tstep = 2 * hstep;
    const unsigned ldsw = (unsigned)wid * 1024u;
    const int aoff = lds_byte(wr * 64 + fr, fq * 8), boff = lds_byte(wc * 32 + fr, fq * 8);
#define PG8_SA(b, h) (((b) * 2 + (h)) * HTB)
#define PG8_SB(b, h) ((4 + (b) * 2 + (h)) * HTB)
#define PG8_STAGE(bufoff, gbase, voff) do { _Pragma("unroll") for (int _i = 0; _i < 2; ++_i) \
        __builtin_amdgcn_global_load_lds((const unsigned*)((const char*)(gbase) + (voff)[_i]), (PG8_LAS unsigned*)(lds + (bufoff) + ldsw + _i * 8192), 16, 0, 0); } while (0)
#define PG8_LDA(dst, b, h) do { _Pragma("unroll") for (int m = 0; m < 4; ++m) _Pragma("unroll") for (int k = 0; k < 2; ++k) dst[m][k] = *(const PG8_LAS bf16x8*)(lds + PG8_SA(b, h) + aoff + m * 2048 + k * 1024); } while (0)
#define PG8_LDB(dst, b, h) do { _Pragma("unroll") for (int n = 0; n < 2; ++n) _Pragma("unroll") for (int k = 0; k < 2; ++k) dst[n][k] = *(const PG8_LAS bf16x8*)(lds + PG8_SB(b, h) + boff + n * 2048 + k * 1024); } while (0)
#define PG8_MMA(ai, bj, At, Bt) do { __builtin_amdgcn_s_setprio(1); _Pragma("unroll") for (int m = 0; m < 4; ++m) _Pragma("unroll") for (int n = 0; n < 2; ++n) _Pragma("unroll") for (int k = 0; k < 2; ++k) \
        acc[ai][bj][m][n] = __builtin_amdgcn_mfma_f32_16x16x32_bf16(Bt[n][k], At[m][k], acc[ai][bj][m][n], 0, 0, 0); __builtin_amdgcn_s_setprio(0); } while (0)
#define PG8_WAIT_V(n) asm volatile("s_waitcnt vmcnt(" #n ")" ::: "memory")
#define PG8_WAIT_L(n) asm volatile("s_waitcnt lgkmcnt(" #n ")" ::: "memory")
#define PG8_BAR __builtin_amdgcn_s_barrier()
#define PG8_SCHED __builtin_amdgcn_sched_barrier(0)
    Unit cur, nxt; int ui = 0;
    if (!S.next(0, cur)) return;
    f32x4 acc[2][2][4][2];
#pragma unroll
    for (int a = 0; a < 2; ++a)
#pragma unroll
        for (int b = 0; b < 2; ++b)
#pragma unroll
            for (int m = 0; m < 4; ++m)
#pragma unroll
                for (int n = 0; n < 2; ++n) acc[a][b][m][n] = (f32x4){0.f, 0.f, 0.f, 0.f};
    bf16x8 At[4][2], B0[2][2], B1[2][2];
    const char* cA = (const char*)g.A + (size_t)cur.pm * tstep; const char* cB = (const char*)g.Bt + (size_t)cur.pn * tstep;
    S.a_ready(cur);
    if constexpr (SP2) {
        PG8_STAGE(PG8_SB(0, 0), cB, voffB); PG8_STAGE(PG8_SB(0, 1), cB + hstep, voffB); PG8_STAGE(PG8_SA(0, 0), cA, voffA); PG8_STAGE(PG8_SA(0, 1), cA + hstep, voffA);
        if (wr == 1) PG8_BAR;
        PG8_WAIT_V(2); PG8_BAR;
        PG8_STAGE(PG8_SB(1, 0), cB + kstep, voffB); PG8_STAGE(PG8_SA(1, 0), cA + kstep, voffA); PG8_STAGE(PG8_SB(1, 1), cB + hstep + kstep, voffB);
        PG8_WAIT_V(6); PG8_BAR;
    } else {
        PG8_STAGE(PG8_SB(0, 0), cB, voffB); PG8_STAGE(PG8_SA(0, 0), cA, voffA); PG8_STAGE(PG8_SB(0, 1), cB + hstep, voffB); PG8_STAGE(PG8_SA(0, 1), cA + hstep, voffA);
        if (wr == 1) PG8_BAR;
        PG8_WAIT_V(4); PG8_BAR;
        PG8_STAGE(PG8_SB(1, 0), cB + kstep, voffB); PG8_STAGE(PG8_SA(1, 0), cA + kstep, voffA); PG8_STAGE(PG8_SB(1, 1), cB + hstep + kstep, voffB);
        PG8_WAIT_V(6); PG8_BAR;
    }
    for (;;) {
        const bool has_next = S.next(ui + 1, nxt);
        const char* nA = has_next ? (const char*)g.A + (size_t)nxt.pm * tstep : cA; const char* nB = has_next ? (const char*)g.Bt + (size_t)nxt.pn * tstep : cB;
        for (int t = 0; t < nt; t += 2) {
            const bool last = (t == nt - 2);
            const char* a1 = cA + (size_t)(t + 1) * kstep;
            const char* a2 = last ? nA : cA + (size_t)(t + 2) * kstep; const char* b2 = last ? nB : cB + (size_t)(t + 2) * kstep;
            const char* a3 = a2 + kstep; const char* b3 = b2 + kstep;
            if (last && has_next) S.a_ready(nxt);
            if constexpr (SP2) {
            PG8_LDB(B0, 0, 0); PG8_LDB(B1, 0, 1); PG8_SCHED; PG8_LDA(At, 0, 0); PG8_STAGE(PG8_SA(1, 1), a1 + hstep, voffA);
            PG8_WAIT_V(8); PG8_WAIT_L(0); PG8_BAR; PG8_MMA(0, 0, At, B0); PG8_MMA(0, 1, At, B1); PG8_BAR; PG8_SCHED;
            PG8_LDA(At, 0, 1); PG8_STAGE(PG8_SB(0, 0), b2, voffB); PG8_STAGE(PG8_SB(0, 1), b2 + hstep, voffB); PG8_STAGE(PG8_SA(0, 0), a2, voffA);
            PG8_WAIT_V(8); PG8_WAIT_L(0); PG8_BAR; PG8_MMA(1, 0, At, B0); PG8_MMA(1, 1, At, B1); PG8_BAR; PG8_SCHED;
            PG8_LDB(B0, 1, 0); PG8_LDB(B1, 1, 1); PG8_SCHED; PG8_LDA(At, 1, 0); PG8_STAGE(PG8_SA(0, 1), a2 + hstep, voffA);
            PG8_WAIT_V(8); PG8_WAIT_L(0); PG8_BAR; PG8_MMA(0, 0, At, B0); PG8_MMA(0, 1, At, B1); PG8_BAR; PG8_SCHED;
            PG8_LDA(At, 1, 1); PG8_STAGE(PG8_SB(1, 0), b3, voffB); PG8_STAGE(PG8_SB(1, 1), b3 + hstep, voffB); PG8_STAGE(PG8_SA(1, 0), a3, voffA);
            PG8_WAIT_V(8); PG8_WAIT_L(0); PG8_BAR; PG8_MMA(1, 0, At, B0); PG8_MMA(1, 1, At, B1); PG8_BAR; PG8_SCHED;
            } else {
            PG8_LDB(B0, 0, 0); PG8_SCHED; PG8_LDA(At, 0, 0); PG8_STAGE(PG8_SA(1, 1), a1 + hstep, voffA);
            PG8_WAIT_L(8); PG8_BAR; PG8_WAIT_L(0); PG8_MMA(0, 0, At, B0); PG8_BAR; PG8_SCHED;
            PG8_LDB(B1, 0, 1); PG8_STAGE(PG8_SB(0, 0), b2, voffB);
            PG8_BAR; PG8_WAIT_L(0); PG8_MMA(0, 1, At, B1); PG8_BAR;
            PG8_LDA(At, 0, 1); PG8_STAGE(PG8_SA(0, 0), a2, voffA);
            PG8_BAR; PG8_WAIT_L(0); PG8_MMA(1, 0, At, B0); PG8_BAR; PG8_SCHED;
            PG8_STAGE(PG8_SB(0, 1), b2 + hstep, voffB);
            PG8_WAIT_V(6); PG8_BAR; PG8_MMA(1, 1, At, B1); PG8_BAR;
            PG8_LDB(B0, 1, 0); PG8_SCHED; PG8_LDA(At, 1, 0); PG8_STAGE(PG8_SA(0, 1), a2 + hstep, voffA);
            PG8_WAIT_L(8); PG8_BAR; PG8_WAIT_L(0); PG8_MMA(0, 0, At, B0); PG8_BAR; PG8_SCHED;
            PG8_LDB(B1, 1, 1); PG8_STAGE(PG8_SB(1, 0), b3, voffB);
            PG8_BAR; PG8_WAIT_L(0); PG8_MMA(0, 1, At, B1); PG8_BAR;
            PG8_LDA(At, 1, 1); PG8_STAGE(PG8_SA(1, 0), a3, voffA);
            PG8_BAR; PG8_WAIT_L(0); PG8_MMA(1, 0, At, B0); PG8_BAR; PG8_SCHED;
            PG8_STAGE(PG8_SB(1, 1), b3 + hstep, voffB);
            PG8_WAIT_V(6); PG8_BAR; PG8_MMA(1, 1, At, B1); PG8_BAR;
            }
        }
        if constexpr (ALIGN_EPI) { if (wr == 0) PG8_BAR; }
        if constexpr (!Epi::AFTER_DRAIN) { E(acc, cur, wr, wc, fr, fq); S.done(cur); }
        if (!has_next) break;
#pragma unroll
        for (int a = 0; a < 2; ++a)
#pragma unroll
            for (int b = 0; b < 2; ++b)
#pragma unroll
                for (int m = 0; m < 4; ++m)
#pragma unroll
                    for (int n = 0; n < 2; ++n) acc[a][b][m][n] = (f32x4){0.f, 0.f, 0.f, 0.f};
        cur = nxt; cA = nA; cB = nB; ++ui;
        if constexpr (ALIGN_EPI) { if (wr == 1) PG8_BAR; }
    }
    PG8_WAIT_V(0);
    if constexpr (!ALIGN_EPI) { if (wr == 0) PG8_BAR; }
    PG8_BAR;
    if constexpr (Epi::AFTER_DRAIN) { E.fused(acc, cur, wr, wc, fr, fq, lds, wid, lane); S.done(cur); }
#undef PG8_SA
#undef PG8_SB
#undef PG8_STAGE
#undef PG8_LDA
#undef PG8_LDB
#undef PG8_MMA
#undef PG8_WAIT_V
#undef PG8_WAIT_L
#undef PG8_BAR
#undef PG8_SCHED
}
}
#include <hip/hip_bf16.h>
#include <cmath>
namespace attn_body {
using bf16=__hip_bfloat16;
using bf16x8=__attribute__((ext_vector_type(8)))short;
using s16x4=__attribute__((ext_vector_type(4)))short;
using f32x16=__attribute__((ext_vector_type(16)))float;
using u32x4=__attribute__((ext_vector_type(4)))unsigned;
constexpr int SEQ=8192,D=64,PQ=512,PKV=128;
constexpr int NW=8,QBLK=32,QB=QBLK*NW,KVBLK=64,NQB=SEQ/QB;
constexpr int ATTN_UNIT_ROWS=QB;
__device__ __forceinline__ int crow(int r,int hi){return (r&3)+8*(r>>2)+4*hi;}
#define SBAR() __builtin_amdgcn_sched_barrier(0)
__device__ __forceinline__ void cmask(f32x16&p0,f32x16&p1,int jb,int qrel,int hi){
  const float NEG=-INFINITY; int kb=64*jb+4*hi;
  #pragma unroll
  for(int r=0;r<16;++r){int kv=kb+(r&3)+8*(r>>2); if(kv>qrel)p0[r]=NEG; if(kv+32>qrel)p1[r]=NEG;}
}

constexpr int NSLOT=3, SLOTB=8192;
constexpr int LDS_K=0, LDS_V=NSLOT*SLOTB, LDS_WS=2*NSLOT*SLOTB, LDS_OST=LDS_WS+NW*64*4, LDS_BYTES=LDS_OST+NW*4096;
constexpr float C2=0.125f*1.4426950408889634f;
__device__ __forceinline__ void glds16(const void*gsrc,unsigned lds_dst){unsigned keep;
  asm volatile("s_mov_b32 %0, m0\n\ts_mov_b32 m0, %2\n\ts_nop 0\n\tglobal_load_lds_dwordx4 %1, off\n\ts_mov_b32 m0, %0":"=&s"(keep):"v"(gsrc),"s"(lds_dst):"memory");}
__device__ __forceinline__ float max3f(float a,float b,float c){float r;asm("v_max3_f32 %0, %1, %2, %3":"=v"(r):"v"(a),"v"(b),"v"(c));return r;}
__device__ __forceinline__ float max2f(float a,float b){float r;asm("v_max_f32_e32 %0, %1, %2":"=v"(r):"v"(a),"v"(b));return r;}
__device__ __forceinline__ float fadd_s(float a,float b){float r;asm("v_add_f32_e32 %0, %1, %2":"=v"(r):"v"(a),"v"(b));return r;}
__device__ __forceinline__ float fsub_s(float a,float b){float r;asm("v_sub_f32_e32 %0, %1, %2":"=v"(r):"v"(a),"v"(b));return r;}
typedef float f32x2_t __attribute__((ext_vector_type(2))); typedef __bf16 bf16x2_t __attribute__((ext_vector_type(2)));
__device__ __forceinline__ unsigned cvtpk_s(float lo,float hi){f32x2_t v={lo,hi};bf16x2_t b=__builtin_convertvector(v,bf16x2_t);return __builtin_bit_cast(unsigned,b);}
#define WAIT_BAR(N) asm volatile("s_waitcnt vmcnt(" #N ") lgkmcnt(0)\n\ts_barrier":::"memory")

__device__ __forceinline__ void qkt(f32x16&p0,f32x16&p1,const char*Kslot,const bf16x8*qr,const f32x16&negm,int r32,int hi){
  const char*kb=Kslot+hi*1024+r32*16;
  #pragma unroll
  for(int d0=0;d0<4;++d0){
    const bf16x8 b0=*reinterpret_cast<const bf16x8*>(kb+d0*2048);
    const bf16x8 b1=*reinterpret_cast<const bf16x8*>(kb+d0*2048+512);
    if(d0==0){p0=__builtin_amdgcn_mfma_f32_32x32x16_bf16(b0,qr[0],negm,0,0,0);p1=__builtin_amdgcn_mfma_f32_32x32x16_bf16(b1,qr[0],negm,0,0,0);}
    else{p0=__builtin_amdgcn_mfma_f32_32x32x16_bf16(b0,qr[d0],p0,0,0,0);p1=__builtin_amdgcn_mfma_f32_32x32x16_bf16(b1,qr[d0],p1,0,0,0);}}
}
typedef __attribute__((address_space(3))) const char* lds_cptr;
typedef short v4i16_t __attribute__((ext_vector_type(4)));
__device__ __forceinline__ void kload8(bf16x8*kf,lds_cptr kp){
  kf[0]=*(const __attribute__((address_space(3))) bf16x8*)(kp);      kf[1]=*(const __attribute__((address_space(3))) bf16x8*)(kp+512);
  kf[2]=*(const __attribute__((address_space(3))) bf16x8*)(kp+2048); kf[3]=*(const __attribute__((address_space(3))) bf16x8*)(kp+2560);
  kf[4]=*(const __attribute__((address_space(3))) bf16x8*)(kp+4096); kf[5]=*(const __attribute__((address_space(3))) bf16x8*)(kp+4608);
  kf[6]=*(const __attribute__((address_space(3))) bf16x8*)(kp+6144); kf[7]=*(const __attribute__((address_space(3))) bf16x8*)(kp+6656);
}
__device__ __forceinline__ void kload2(bf16x8*kf,lds_cptr kp,int j){ kf[2*j]=*(const __attribute__((address_space(3))) bf16x8*)(kp+j*2048); kf[2*j+1]=*(const __attribute__((address_space(3))) bf16x8*)(kp+j*2048+512); }
__device__ __forceinline__ s16x4 vtr(lds_cptr p){ return __builtin_bit_cast(s16x4,__builtin_amdgcn_ds_read_tr16_b64_v4i16((__attribute__((address_space(3))) v4i16_t*)p)); }
__device__ __forceinline__ float rowmax(const f32x16&p0,const f32x16&p1){
  float a=max3f(p0[0],p0[1],p1[0]),b=max3f(p0[2],p0[3],p1[1]);a=max3f(a,p1[2],p1[3]);
  #pragma unroll
  for(int r=4;r<16;r+=4){a=max3f(a,p0[r],p0[r+1]);b=max3f(b,p0[r+2],p0[r+3]);a=max3f(a,p1[r],p1[r+1]);b=max3f(b,p1[r+2],p1[r+3]);}
  const float m=max2f(a,b);
  auto rr=__builtin_amdgcn_permlane32_swap(__float_as_uint(m),__float_as_uint(m),false,false);
  return max2f(__uint_as_float(rr[0]),__uint_as_float(rr[1]));
}
__device__ __forceinline__ void pv(f32x16*o,int vb,bf16x8 pa0,bf16x8 pa1,bf16x8 pa2,bf16x8 pa3){
  #pragma unroll
  for(int d0=0;d0<2;++d0){s16x4 lo[4],hi[4];
    #pragma unroll
    for(int ks=0;ks<4;++ks){
      asm volatile("ds_read_b64_tr_b16 %0,%1 offset:%c2":"=&v"(lo[ks]):"v"(vb),"i"(d0*4096+ks*1024):"memory");
      asm volatile("ds_read_b64_tr_b16 %0,%1 offset:%c2":"=&v"(hi[ks]):"v"(vb),"i"(d0*4096+ks*1024+512):"memory");}
    asm volatile("s_waitcnt lgkmcnt(0)":::"memory");SBAR();
    #define PK(k) (bf16x8){lo[k][0],lo[k][1],lo[k][2],lo[k][3],hi[k][0],hi[k][1],hi[k][2],hi[k][3]}
    o[d0]=__builtin_amdgcn_mfma_f32_32x32x16_bf16(pa0,PK(0),o[d0],0,0,0);
    o[d0]=__builtin_amdgcn_mfma_f32_32x32x16_bf16(pa1,PK(1),o[d0],0,0,0);
    o[d0]=__builtin_amdgcn_mfma_f32_32x32x16_bf16(pa2,PK(2),o[d0],0,0,0);
    o[d0]=__builtin_amdgcn_mfma_f32_32x32x16_bf16(pa3,PK(3),o[d0],0,0,0);
    #undef PK
  }
}

#ifndef ATTN_STORE16
#define ATTN_STORE16(p,v) (*(u32x4*)(p)=(v))
#endif
template<int THRL> __device__ __forceinline__ void attn_unit(int b,int h,int kvh,int qb,const bf16*Q,const bf16*__restrict__ K,const bf16*__restrict__ V,bf16*O,char*shm){
  int tid_raw=threadIdx.x; asm volatile("":"+v"(tid_raw));
  const int tid=tid_raw,lane=tid&63,r32=lane&31,hi=lane>>5; const int wid=__builtin_amdgcn_readfirstlane(tid>>6);
  const long rowbase=(long)b*SEQ; const int q0=qb*QB;
  const bf16*Qw=Q+(rowbase+q0+wid*QBLK)*PQ+h*D;
  const bf16*Kh=K+rowbase*PKV+kvh*D,*Vh=V+rowbase*PKV+kvh*D;
  const unsigned lds0=(unsigned)(uintptr_t)shm;
  float*wsf=(float*)(shm+LDS_WS)+wid*64;
  const bf16*ksrc=Kh+(long)lane*PKV+wid*8;
  const bf16*vsrc=Vh+(long)(16*(wid&3)+(lane>>2))*PKV+(wid>>2)*32+(lane&3)*8;
  const unsigned kdst=lds0+LDS_K+wid*1024, vdst=lds0+LDS_V+wid*1024;
  #define DMA_K(t,slot) glds16(ksrc+(long)(t)*KVBLK*PKV,(unsigned)__builtin_amdgcn_readfirstlane(kdst+(slot)))
  #define DMA_V(t,slot) glds16(vsrc+(long)(t)*KVBLK*PKV,(unsigned)__builtin_amdgcn_readfirstlane(vdst+(slot)))
  const int vb0=(int)(lds0+LDS_V)+((lane>>4)&1)*32+(lane&3)*8+(4*hi+((lane&15)>>2))*64;
  const char*Kbase=shm+LDS_K; bf16x8 kf[8];
  const lds_cptr shm3=(lds_cptr)shm; const lds_cptr kp0=shm3+LDS_K+hi*1024+r32*16; const lds_cptr vp0=shm3+LDS_V+((lane>>4)&1)*32+(lane&3)*8+(4*hi+((lane&15)>>2))*64;
  const int NT=SEQ/KVBLK;
  DMA_K(0,0);DMA_V(0,0);DMA_K(1,SLOTB);
  bf16x8 qr[4];
  #pragma unroll
  for(int d0=0;d0<4;++d0)qr[d0]=*reinterpret_cast<const bf16x8*>(&Qw[(long)r32*PQ+d0*16+hi*8]);
  float mhat=0.f,l_reg=0.f;f32x16 o[2];o[0]=f32x16{};o[1]=f32x16{};f32x16 negm=f32x16{};asm volatile("":"+v"(negm));
  const int qrel=wid*QBLK+r32;
  #define CMASK(P0,P1,t) do{}while(0)
  bool resc=false;
  #define START(P0,P1) do{ const float rm=rowmax(P0,P1); resc=false; \
    { const float dl=rm; mhat=fadd_s(mhat,dl); \
      _Pragma("unroll") for(int r=0;r<16;++r){P0[r]=fsub_s(P0[r],dl);P1[r]=fsub_s(P1[r],dl);} \
      _Pragma("unroll") for(int r=0;r<16;++r)negm[r]=-mhat; asm volatile("":"+v"(negm)); } \
    _Pragma("unroll") for(int r=0;r<16;++r)P0[r]=__builtin_amdgcn_exp2f(P0[r]); }while(0)
  #define RESC() do{ if(resc){ asm volatile("s_waitcnt lgkmcnt(0)":::"memory"); \
      _Pragma("unroll") for(int d_=0;d_<2;++d_) _Pragma("unroll") for(int r=0;r<16;++r)o[d_][r]*=wsf[crow(r,hi)]; } }while(0)
  f32x16 pA0,pA1,pB0,pB1;
  int sl_prev=0,sl_cur=0,sl_next=SLOTB;
  #define ROT() do{sl_prev=sl_cur;sl_cur=sl_next;sl_next=(sl_next==(NSLOT-1)*SLOTB)?0:sl_next+SLOTB;}while(0)
  DMA_K(2,2*SLOTB);
  WAIT_BAR(3);
  qkt(pA0,pA1,Kbase,qr,negm,r32,hi);asm volatile("s_nop 15\n\ts_nop 7":"+v"(pA0),"+v"(pA1));CMASK(pA0,pA1,0);
  START(pA0,pA1);
  _Pragma("unroll") for(int r=0;r<16;++r)pA1[r]=__builtin_amdgcn_exp2f(pA1[r]);
  WAIT_BAR(0);
  DMA_K(3,0);DMA_V(1,SLOTB);
  ROT();
  kload8(kf,kp0+sl_cur);
  WAIT_BAR(2);
  s16x4 vlo[8],vhi[8]; u32x4 pw0,pw1,pw2,pw3;
  #define PKW(P,B) cvtpk_s(P[B],P[B+1])
  #define PAF(k) __builtin_bit_cast(bf16x8,pw##k)
  #define VFR(i) (bf16x8){vlo[i][0],vlo[i][1],vlo[i][2],vlo[i][3],vhi[i][0],vhi[i][1],vhi[i][2],vhi[i][3]}
  #define PIN(x) asm volatile("":"+v"(x))
  #define MX3(a,b,c) __builtin_fmaxf(__builtin_fmaxf((a),(b)),(c))
  #define GAPA(MF,A0,A1,A2,A3,W0,W1,PW) do{ MF; sacc+=A0; sacc+=A1; sacc+=A2; sacc+=A3; PIN(sacc); W0; W1; PIN(PW); SBAR(); }while(0)
  #define EX(v) __builtin_amdgcn_exp2f(v)
  #define GAPB(MF,X,B) do{ MF; X[B]=EX(X[B]); X[B+1]=EX(X[B+1]); X[B+2]=EX(X[B+2]); X[B+3]=EX(X[B+3]); PIN(X); SBAR(); }while(0)
  #define VRD(i) do{ vlo[i]=vtr(vp_+(((i)>>2)*4096+((i)&3)*1024)); vhi[i]=vtr(vp_+(((i)>>2)*4096+((i)&3)*1024+512)); }while(0)
  #define KRD(G,j) do{ if(G){ kload2(kf,kp0+sl_next,j); SBAR(); } }while(0)
  #define STEP(C0,C1,P0,P1,t,GK,GV,GL) do{ SBAR(); \
    const lds_cptr vp_=vp0+sl_prev; \
    VRD(0); SBAR(); float sacc=(P0[0]+P0[1]); \
    GAPA(C0=__builtin_amdgcn_mfma_f32_32x32x16_bf16(kf[0],qr[0],negm,0,0,0), P0[2],P0[3],P0[4],P0[5],     pw0[0]=PKW(P0,0), pw0[1]=PKW(P0,2), pw0); \
    VRD(4); SBAR(); GAPA(C1=__builtin_amdgcn_mfma_f32_32x32x16_bf16(kf[1],qr[0],negm,0,0,0), P0[6],P0[7],P0[8],P0[9],     pw0[2]=PKW(P0,4), pw0[3]=PKW(P0,6), pw0); \
    VRD(1); SBAR(); GAPA(C0=__builtin_amdgcn_mfma_f32_32x32x16_bf16(kf[2],qr[1],C0,0,0,0),   P0[10],P0[11],P0[12],P0[13], pw1[0]=PKW(P0,8), pw1[1]=PKW(P0,10), pw1); \
    VRD(5); SBAR(); GAPA(C1=__builtin_amdgcn_mfma_f32_32x32x16_bf16(kf[3],qr[1],C1,0,0,0),   P0[14],P0[15],P1[0],P1[1],   pw1[2]=PKW(P0,12),pw1[3]=PKW(P0,14), pw1); \
    VRD(2); SBAR(); GAPA(C0=__builtin_amdgcn_mfma_f32_32x32x16_bf16(kf[4],qr[2],C0,0,0,0),   P1[2],P1[3],P1[4],P1[5],     pw2[0]=PKW(P1,0), pw2[1]=PKW(P1,2), pw2); \
    VRD(6); SBAR(); GAPA(C1=__builtin_amdgcn_mfma_f32_32x32x16_bf16(kf[5],qr[2],C1,0,0,0),   P1[6],P1[7],P1[8],P1[9],     pw2[2]=PKW(P1,4), pw2[3]=PKW(P1,6), pw2); \
    VRD(3); SBAR(); GAPA(C0=__builtin_amdgcn_mfma_f32_32x32x16_bf16(kf[6],qr[3],C0,0,0,0),   P1[10],P1[11],P1[12],P1[13], pw3[0]=PKW(P1,8), pw3[1]=PKW(P1,10), pw3); \
    VRD(7); SBAR(); GAPA(C1=__builtin_amdgcn_mfma_f32_32x32x16_bf16(kf[7],qr[3],C1,0,0,0),   P1[14],P1[15],0.f,0.f,       pw3[2]=PKW(P1,12),pw3[3]=PKW(P1,14), pw3); \
    l_reg+=sacc; \
    if(GK){DMA_K((t)+3,sl_cur);} if(GV){DMA_V((t)+1,sl_next);} \
    CMASK(C0,C1,t); \
    { float a=MX3(C0[0],C0[1],C1[0]),b=MX3(C0[2],C0[3],C1[1]); a=MX3(a,C1[2],C1[3]); \
      _Pragma("unroll") for(int r=4;r<16;r+=4){a=MX3(a,C0[r],C0[r+1]);b=MX3(b,C0[r+2],C0[r+3]);a=MX3(a,C1[r],C1[r+1]);b=MX3(b,C1[r+2],C1[r+3]);} \
      float rm=__builtin_fmaxf(a,b); { auto rr=__builtin_amdgcn_permlane32_swap(__float_as_uint(rm),__float_as_uint(rm),false,false); rm=__builtin_fmaxf(__uint_as_float(rr[0]),__uint_as_float(rr[1])); } \
      resc=false; \
      if(__builtin_expect(__any(rm>(float)THRL),0)){ const float dl=__builtin_fmaxf(rm,0.f); mhat+=dl; \
        _Pragma("unroll") for(int r=0;r<16;++r){C0[r]-=dl;C1[r]-=dl;} \
        _Pragma("unroll") for(int r=0;r<16;++r)negm[r]=-mhat; asm volatile("":"+v"(negm)); \
        const float f=__builtin_amdgcn_exp2f(-dl); l_reg*=f; if(hi==0)wsf[r32]=f; resc=true; } } \
    SBAR(); \
    GAPB(o[0]=__builtin_amdgcn_mfma_f32_32x32x16_bf16(PAF(0),VFR(0),o[0],0,0,0), C0,0); \
    GAPB(o[1]=__builtin_amdgcn_mfma_f32_32x32x16_bf16(PAF(0),VFR(4),o[1],0,0,0), C0,4); \
    KRD(GL,0); GAPB(o[0]=__builtin_amdgcn_mfma_f32_32x32x16_bf16(PAF(1),VFR(1),o[0],0,0,0), C0,8); \
    KRD(GL,1); GAPB(o[1]=__builtin_amdgcn_mfma_f32_32x32x16_bf16(PAF(1),VFR(5),o[1],0,0,0), C0,12); \
    KRD(GL,2); GAPB(o[0]=__builtin_amdgcn_mfma_f32_32x32x16_bf16(PAF(2),VFR(2),o[0],0,0,0), C1,0); \
    KRD(GL,3); GAPB(o[1]=__builtin_amdgcn_mfma_f32_32x32x16_bf16(PAF(2),VFR(6),o[1],0,0,0), C1,4); \
    GAPB(o[0]=__builtin_amdgcn_mfma_f32_32x32x16_bf16(PAF(3),VFR(3),o[0],0,0,0), C1,8); \
    GAPB(o[1]=__builtin_amdgcn_mfma_f32_32x32x16_bf16(PAF(3),VFR(7),o[1],0,0,0), C1,12); \
    }while(0)
  int t=1;
  #undef CMASK
  #define CMASK(P0,P1,t) do{}while(0)
  for(;t+5<NT;t+=2){
    STEP(pB0,pB1,pA0,pA1,t,true,true,true);     WAIT_BAR(2); RESC(); ROT();
    STEP(pA0,pA1,pB0,pB1,t+1,true,true,true);   WAIT_BAR(2); RESC(); ROT();
  }
  #undef CMASK
  #define CMASK(P0,P1,t) do{}while(0)
  #define ENDW(tt) do{ if((tt)+3<NT){WAIT_BAR(2);} else if((tt)+2<NT){WAIT_BAR(1);} else {WAIT_BAR(0);} }while(0)
  for(;t+1<NT;t+=2){
    STEP(pB0,pB1,pA0,pA1,t,(t+3<NT),(t+1<NT),(t+1<NT));       ENDW(t);   RESC(); ROT();
    STEP(pA0,pA1,pB0,pB1,t+1,(t+4<NT),(t+2<NT),(t+2<NT));     ENDW(t+1); RESC(); ROT();
  }
  STEP(pB0,pB1,pA0,pA1,NT-1,false,false,false); RESC();
  { float sacc=pB0[0]+pB0[1]; _Pragma("unroll") for(int r=2;r<16;++r)sacc+=pB0[r]; _Pragma("unroll") for(int r=0;r<16;++r)sacc+=pB1[r]; l_reg+=sacc;
    pw0=(u32x4){PKW(pB0,0),PKW(pB0,2),PKW(pB0,4),PKW(pB0,6)};pw1=(u32x4){PKW(pB0,8),PKW(pB0,10),PKW(pB0,12),PKW(pB0,14)};pw2=(u32x4){PKW(pB1,0),PKW(pB1,2),PKW(pB1,4),PKW(pB1,6)};pw3=(u32x4){PKW(pB1,8),PKW(pB1,10),PKW(pB1,12),PKW(pB1,14)};
    SBAR(); pv(o,vb0+sl_cur,PAF(0),PAF(1),PAF(2),PAF(3)); }
  #undef PKW
  #undef PAF
  #undef VFR
  #undef PIN
  #undef MX3
  #undef GAPA
  #undef GAPB
  #undef EX
  #undef VRD
  #undef KRD
  #undef STEP
  #undef ENDW
  {auto rr=__builtin_amdgcn_permlane32_swap(__float_as_uint(l_reg),__float_as_uint(l_reg),false,false);l_reg=__uint_as_float(rr[0])+__uint_as_float(rr[1]);}
  if(hi==0)wsf[32+r32]=l_reg;asm volatile("s_waitcnt lgkmcnt(0)":::"memory");
  float rli[16];
  #pragma unroll
  for(int r=0;r<16;++r)rli[r]=__builtin_amdgcn_rcpf(wsf[32+crow(r,hi)]);
  bf16*Ow=O+(rowbase+q0+wid*QBLK)*PQ+h*D;
  { bf16*stg=(bf16*)(shm+LDS_OST)+wid*2048;
    #pragma unroll
    for(int r=0;r<16;++r){const int orow=crow(r,hi);
      #pragma unroll
      for(int d0=0;d0<2;++d0)stg[orow*64+d0*32+r32]=__float2bfloat16(o[d0][r]*rli[r]);}
    asm volatile("s_waitcnt lgkmcnt(0)":::"memory");
    #pragma unroll
    for(int i=0;i<4;++i){const int row=i*8+(lane>>3),ch=lane&7; const u32x4 v=*(const u32x4*)(stg+row*64+ch*8); ATTN_STORE16(Ow+(long)row*PQ+ch*8,v);} }
  asm volatile("s_waitcnt lgkmcnt(0)\n\ts_barrier":::"memory");
  #undef DMA_K
  #undef DMA_V
  #undef CMASK
  #undef START
  #undef RESC
  #undef ROT
}
constexpr int ATTN_LDS_BYTES=LDS_BYTES;
#undef SBAR
#undef WAIT_BAR
}
#define LAS __attribute__((address_space(3)))
constexpr int SEQ = 8192, BATCH = 4, MTOK = BATCH * SEQ, DMODEL = 1024, DEPTH = 4, DFF = 2816, INW = 6656, GATEW = 3072;
constexpr float RMS_EPS = 1e-6f;
constexpr float QSCALE = 0.125f * 1.4426950408889634f;
constexpr int NWAVES = 8;
typedef pg8::bf16_t bf16_t;
typedef pg8::f32x4 f32x4;
typedef pg8::bf16x8 bf16x8;
typedef unsigned u32x2 __attribute__((ext_vector_type(2)));
typedef unsigned u32x4v __attribute__((ext_vector_type(4)));

constexpr size_t W_IN = 0, W_A = W_IN + (size_t)INW * 1024, W_B = W_A + 1024 * 512, W_C = W_B + 1024 * 256, W_O3 = W_C + 1024 * 512,
                 W_GU = W_O3 + (size_t)1024 * 3072, W_D = W_GU + (size_t)2 * DFF * 1024, W_LAYER = W_D + (size_t)1024 * DFF;
static_assert(W_LAYER * 2 == 38u * 1048576u, "weight block is 38 MiB");
constexpr size_t MiB = 1u << 20;
constexpr size_t WS_W = 1 * MiB, WS_H = 153 * MiB, WS_QA = 217 * MiB, WS_OB = 249 * MiB, WS_PC = 265 * MiB, WS_BIG = 297 * MiB, WS_PSS1 = 489 * MiB, WS_PSS2 = 491 * MiB, WS_END = 493 * MiB;
constexpr size_t BIG_KA = 0, BIG_VA = 8 * MiB, BIG_QB = 16 * MiB, BIG_KB = 64 * MiB, BIG_VB = 112 * MiB, BIG_UC = 160 * MiB;
constexpr int LDS_BYTES = 147456;

__device__ __forceinline__ float bf2f(unsigned short h) { return __builtin_bit_cast(float, (unsigned)h << 16); }
__device__ __forceinline__ float bflo(unsigned w) { return __builtin_bit_cast(float, w << 16); }
__device__ __forceinline__ float bfhi(unsigned w) { return __builtin_bit_cast(float, w & 0xffff0000u); }
__device__ __forceinline__ unsigned pkbf(float lo, float hi) { return pg8::cvt_pk_bf16(lo, hi); }
__device__ __forceinline__ int finv(int f) { return (f & ~255) | (((f >> 5) & 1) << 7) | (((f >> 6) & 3) << 5) | (f & 31); }
__device__ __forceinline__ void sincos_rad(float ang, float& s, float& c) { float r = __builtin_amdgcn_fractf(ang * 0.15915494309189535f); s = __builtin_amdgcn_sinf(r); c = __builtin_amdgcn_cosf(r); }
__device__ __forceinline__ float sigmoidf_(float v) { return __builtin_amdgcn_rcpf(1.0f + __builtin_amdgcn_exp2f(-1.4426950408889634f * v)); }

__device__ __forceinline__ float row_rs(const float* PSS, int row) { const pg8::f32x4* p = (const pg8::f32x4*)(PSS + (size_t)row * 16); const pg8::f32x4 s = (p[0] + p[1]) + (p[2] + p[3]);
    return __builtin_amdgcn_rsqf(((s[0] + s[1]) + (s[2] + s[3])) * (1.f / DMODEL) + RMS_EPS); }
namespace pg8 {
struct EpiInProj1 {
    static constexpr bool PERM = false, AFTER_DRAIN = false;
    bf16_t *QA, *KA, *VA, *QB, *KB, *VB, *UC; const float *qn_a, *kn_a, *qn_b, *kn_b; const float* PSS;
    __device__ __forceinline__ void operator()(const f32x4 (&acc)[2][2][4][2], const Unit& u, int wr, int wc, int fr, int fq) const {
        const int f0 = u.pn * BM + wc * 64;
        bf16_t* dst; int ld, mode; const float* gain = nullptr; float osc = 1.f;
        if (f0 < 512) { dst = QA + f0; ld = 512; mode = 1; gain = qn_a; osc = QSCALE; }
        else if (f0 < 640) { dst = KA + (f0 - 512); ld = 128; mode = 1; gain = kn_a; }
        else if (f0 < 768) { dst = VA + (f0 - 640); ld = 128; mode = 0; }
        else if (f0 < 1536) { dst = QB + (f0 - 768); ld = 768; mode = 2; gain = qn_b; osc = QSCALE; }
        else if (f0 < 2304) { dst = KB + (f0 - 1536); ld = 768; mode = 2; gain = kn_b; }
        else if (f0 < 3072) { dst = VB + (f0 - 2304); ld = 768; mode = 0; }
        else { dst = UC + (f0 - 3072); ld = 512; mode = 0; }
        const int row0 = u.pm * BM + wr * 64 + fr;
        if (mode == 0) {
#pragma unroll
            for (int ai = 0; ai < 2; ++ai)
#pragma unroll
                for (int m = 0; m < 4; ++m) { bf16_t* rp = dst + (size_t)(row0 + ai * HALF + m * 16) * ld + 4 * fq; const float rsx = row_rs(PSS, row0 + ai * HALF + m * 16);
#pragma unroll
                    for (int bj = 0; bj < 2; ++bj)
#pragma unroll
                        for (int n = 0; n < 2; ++n) { const f32x4 v = acc[ai][bj][m][n] * rsx; u32x2 w; w.x = cvt_pk_bf16(v[0], v[1]); w.y = cvt_pk_bf16(v[2], v[3]); *(u32x2*)(rp + 32 * bj + 16 * n) = w; } }
            return;
        }
        float inv[2][4];
        const float L2T = 13.287712379549449f;
#pragma unroll
        for (int n = 0; n < 2; ++n)
#pragma unroll
            for (int j = 0; j < 4; ++j) inv[n][j] = (mode == 2) ? __builtin_amdgcn_exp2f(-(float)(16 * n + 4 * fq + j) * (L2T / 32.f)) : __builtin_amdgcn_exp2f(-(float)(4 * fq + j) * (L2T / 16.f));
#pragma unroll
        for (int ai = 0; ai < 2; ++ai)
#pragma unroll
            for (int m = 0; m < 4; ++m) {
                const int row = row0 + ai * HALF + m * 16; const int t = row & (SEQ - 1); const float rsx = row_rs(PSS, row);
                float ss = 0.f;
#pragma unroll
                for (int bj = 0; bj < 2; ++bj)
#pragma unroll
                    for (int n = 0; n < 2; ++n) { const f32x4 v = acc[ai][bj][m][n] * rsx; ss += (v[0] * v[0] + v[1] * v[1]) + (v[2] * v[2] + v[3] * v[3]); }
                ss += __shfl_xor(ss, 16); ss += __shfl_xor(ss, 32);
                const float rs = __builtin_amdgcn_rsqf(ss * (1.f / 64.f) + RMS_EPS);
                f32x4 y[2][2], o[2][2];
#pragma unroll
                for (int bj = 0; bj < 2; ++bj)
#pragma unroll
                    for (int n = 0; n < 2; ++n) y[bj][n] = acc[ai][bj][m][n] * (rs * rsx) * *(const f32x4*)(gain + 32 * bj + 16 * n + 4 * fq);
                if (mode == 2) {
                    const float tf = (float)t;
#pragma unroll
                    for (int n = 0; n < 2; ++n)
#pragma unroll
                        for (int j = 0; j < 4; ++j) { float s, c; sincos_rad(tf * inv[n][j], s, c); const float x1 = y[0][n][j], x2 = y[1][n][j]; o[0][n][j] = x1 * c - x2 * s; o[1][n][j] = x2 * c + x1 * s; }
                } else {
#pragma unroll
                    for (int bj = 0; bj < 2; ++bj) { const float pf = (float)(bj == 0 ? (t >> 6) : (t & 63));
#pragma unroll
                        for (int j = 0; j < 4; ++j) { float s, c; sincos_rad(pf * inv[0][j], s, c); const float x1 = y[bj][0][j], x2 = y[bj][1][j]; o[bj][0][j] = x1 * c - x2 * s; o[bj][1][j] = x2 * c + x1 * s; } }
                }
                bf16_t* rp = dst + (size_t)row * ld + 4 * fq;
#pragma unroll
                for (int bj = 0; bj < 2; ++bj)
#pragma unroll
                    for (int n = 0; n < 2; ++n) { const f32x4 v = o[bj][n] * osc; u32x2 w; w.x = cvt_pk_bf16(v[0], v[1]); w.y = cvt_pk_bf16(v[2], v[3]); *(u32x2*)(rp + 32 * bj + 16 * n) = w; }
            }
    }
};
struct EpiGates {
    static constexpr bool PERM = false, AFTER_DRAIN = false;
    bf16_t* G; const float* bias; const float* PSS;
    __device__ __forceinline__ void operator()(const f32x4 (&acc)[2][2][4][2], const Unit& u, int wr, int wc, int fr, int fq) const {
        const int row0 = u.pm * BM + wr * 64 + fr, col0 = u.pn * BM + wc * 64 + 4 * fq;
        float rsx[2][4];
#pragma unroll
        for (int ai = 0; ai < 2; ++ai)
#pragma unroll
            for (int m = 0; m < 4; ++m) rsx[ai][m] = row_rs(PSS, row0 + ai * HALF + m * 16);
#pragma unroll
        for (int bj = 0; bj < 2; ++bj)
#pragma unroll
            for (int n = 0; n < 2; ++n) { const int col = col0 + 32 * bj + 16 * n; const f32x4 b = *(const f32x4*)(bias + col);
#pragma unroll
                for (int ai = 0; ai < 2; ++ai)
#pragma unroll
                    for (int m = 0; m < 4; ++m) { const f32x4 v = acc[ai][bj][m][n] * rsx[ai][m] + b; u32x2 w; w.x = cvt_pk_bf16(sigmoidf_(v[0]), sigmoidf_(v[1])); w.y = cvt_pk_bf16(sigmoidf_(v[2]), sigmoidf_(v[3]));
                        *(u32x2*)(G + (size_t)(row0 + ai * HALF + m * 16) * GATEW + col) = w; } }
    }
};
struct EpiMerge {
    static constexpr bool PERM = false, AFTER_DRAIN = false;
    const bf16_t* G; bf16_t* Mo; int coloff; int first;
    __device__ __forceinline__ void operator()(const f32x4 (&acc)[2][2][4][2], const Unit& u, int wr, int wc, int fr, int fq) const {
        const int row0 = u.pm * BM + wr * 64 + fr, col0 = u.pn * BM + wc * 64 + 4 * fq;
#pragma unroll
        for (int ai = 0; ai < 2; ++ai)
#pragma unroll
            for (int m = 0; m < 4; ++m) { const int row = row0 + ai * HALF + m * 16; const bf16_t* gp = G + (size_t)row * GATEW + coloff + col0; bf16_t* mp = Mo + (size_t)row * DMODEL + col0;
                u32x2 gv[2][2], mv[2][2];
#pragma unroll
                for (int bj = 0; bj < 2; ++bj)
#pragma unroll
                    for (int n = 0; n < 2; ++n) { gv[bj][n] = *(const u32x2*)(gp + 32 * bj + 16 * n); mv[bj][n] = first ? (u32x2){0u, 0u} : *(const u32x2*)(mp + 32 * bj + 16 * n); }
#pragma unroll
                for (int bj = 0; bj < 2; ++bj)
#pragma unroll
                    for (int n = 0; n < 2; ++n) { const f32x4 v = acc[ai][bj][m][n]; const u32x2 gg = gv[bj][n], mm = mv[bj][n]; u32x2 w;
                        w.x = cvt_pk_bf16(bflo(mm.x) + bflo(gg.x) * v[0], bfhi(mm.x) + bfhi(gg.x) * v[1]); w.y = cvt_pk_bf16(bflo(mm.y) + bflo(gg.y) * v[2], bfhi(mm.y) + bfhi(gg.y) * v[3]); *(u32x2*)(mp + 32 * bj + 16 * n) = w; } }
    }
};
struct EpiRes {
    static constexpr bool PERM = false, AFTER_DRAIN = false;
    const float* base; float* out; bf16_t* XB; float* PSS;
    __device__ __forceinline__ void operator()(const f32x4 (&acc)[2][2][4][2], const Unit& u, int wr, int wc, int fr, int fq) const {
        const int row0 = u.pm * BM + wr * 64 + fr, col0 = u.pn * BM + wc * 64 + 4 * fq;
#pragma unroll
        for (int ai = 0; ai < 2; ++ai)
#pragma unroll
            for (int m = 0; m < 4; ++m) { const int row = row0 + ai * HALF + m * 16; const size_t off = (size_t)row * DMODEL + col0;
                f32x4 bv[2][2];
#pragma unroll
                for (int bj = 0; bj < 2; ++bj)
#pragma unroll
                    for (int n = 0; n < 2; ++n) bv[bj][n] = *(const f32x4*)(base + off + 32 * bj + 16 * n);
                float ss = 0.f;
#pragma unroll
                for (int bj = 0; bj < 2; ++bj)
#pragma unroll
                    for (int n = 0; n < 2; ++n) { const f32x4 x = bv[bj][n] + acc[ai][bj][m][n]; *(f32x4*)(out + off + 32 * bj + 16 * n) = x; ss += (x[0] * x[0] + x[1] * x[1]) + (x[2] * x[2] + x[3] * x[3]);
                        u32x2 w; w.x = cvt_pk_bf16(x[0], x[1]); w.y = cvt_pk_bf16(x[2], x[3]); *(u32x2*)(XB + off + 32 * bj + 16 * n) = w; }
                ss += __shfl_xor(ss, 16); ss += __shfl_xor(ss, 32);
                if (fq == 0) PSS[(size_t)row * 16 + u.pn * 4 + wc] = ss; }
    }
};
struct EpiFfn1 {
    static constexpr bool PERM = false, AFTER_DRAIN = false;
    bf16_t* ACT; const float* PSS;
    __device__ __forceinline__ void operator()(const f32x4 (&acc)[2][2][4][2], const Unit& u, int wr, int wc, int fr, int fq) const {
        const int row0 = u.pm * BM + wr * 64 + fr, col0 = u.pn * HALF + wc * 32 + 4 * fq;
#pragma unroll
        for (int ai = 0; ai < 2; ++ai)
#pragma unroll
            for (int m = 0; m < 4; ++m) { bf16_t* rp = ACT + (size_t)(row0 + ai * HALF + m * 16) * DFF + col0; const float rsx = row_rs(PSS, row0 + ai * HALF + m * 16);
#pragma unroll
                for (int n = 0; n < 2; ++n) { const f32x4 gt = acc[ai][0][m][n] * rsx, up = acc[ai][1][m][n] * rsx; f32x4 r;
#pragma unroll
                    for (int j = 0; j < 4; ++j) r[j] = gt[j] * sigmoidf_(gt[j]) * up[j];
                    u32x2 w; w.x = cvt_pk_bf16(r[0], r[1]); w.y = cvt_pk_bf16(r[2], r[3]); *(u32x2*)(rp + 16 * n) = w; } }
    }
};
}

namespace attnb {
typedef short s16x4 __attribute__((ext_vector_type(4)));
typedef short v4i16_t __attribute__((ext_vector_type(4)));
constexpr int PB = 768, VROW = 144, WAVE_LDS = 32 * VROW;
__device__ __forceinline__ s16x4 vtr(LAS const char* p) { return __builtin_bit_cast(s16x4, __builtin_amdgcn_ds_read_tr16_b64_v4i16((LAS v4i16_t*)p)); }

template <int DIL>
__device__ __forceinline__ void group(const bf16_t* __restrict__ Qg, const bf16_t* __restrict__ Kg, const bf16_t* __restrict__ Vg, int t0r, LAS char* vl, int lane, float& m_run, float& l_run, f32x4 (&o)[4]) {
    constexpr int STEP = 16 / DIL, NK = 15 * STEP + 129, NC = (NK + 31) / 32, LD = SEQ / DIL;
    const int fr = lane & 15, fq = lane >> 4;
    const int rr = t0r & (DIL - 1), lk0 = t0r / DIL - 64;
    bf16x8 qf[2];
    { const bf16_t* qp = Qg + (size_t)(t0r + 16 * fr) * PB + 8 * fq; qf[0] = *(const bf16x8*)qp; qf[1] = *(const bf16x8*)(qp + 32); }
    bf16x8 kf[2][2][2], vr[2][4];
#define AB_LOAD(c, B) do { \
        _Pragma("unroll") for (int T = 0; T < 2; ++T) { int lk = lk0 + 32 * (c) + 16 * T + fr; lk = lk < 0 ? 0 : (lk > LD - 1 ? LD - 1 : lk); \
            const bf16_t* kp = Kg + (size_t)(lk * DIL + rr) * PB + 8 * fq; kf[B][T][0] = *(const bf16x8*)kp; kf[B][T][1] = *(const bf16x8*)(kp + 32); } \
        _Pragma("unroll") for (int i = 0; i < 4; ++i) { int lk = lk0 + 32 * (c) + (lane >> 3) + 8 * i; lk = lk < 0 ? 0 : (lk > LD - 1 ? LD - 1 : lk); \
            vr[B][i] = *(const bf16x8*)(Vg + (size_t)(lk * DIL + rr) * PB + 8 * (lane & 7)); } } while (0)
    AB_LOAD(0, 0);
    LAS char* vw = vl + (lane >> 3) * VROW + (lane & 7) * 16;
    LAS const char* vrd = vl + (4 * fq + (fr >> 2)) * VROW + (fr & 3) * 8;
#define AB_COMPUTE(c, B) do { \
_Pragma("unroll") \
        for (int i = 0; i < 4; ++i) *(LAS bf16x8*)(vw + 8 * i * VROW) = vr[B][i]; \
        f32x4 s[2]; \
_Pragma("unroll") \
        for (int T = 0; T < 2; ++T) { s[T] = __builtin_amdgcn_mfma_f32_16x16x32_bf16(kf[B][T][0], qf[0], (f32x4){0.f, 0.f, 0.f, 0.f}, 0, 0, 0); s[T] = __builtin_amdgcn_mfma_f32_16x16x32_bf16(kf[B][T][1], qf[1], s[T], 0, 0, 0); } \
        bool ok[2][4]; float mx = -1e30f; \
_Pragma("unroll") \
        for (int T = 0; T < 2; ++T) \
_Pragma("unroll") \
            for (int r = 0; r < 4; ++r) { const int k = 32 * (c) + 16 * T + 4 * fq + r, lk = lk0 + k; ok[T][r] = (lk >= 0) && (lk < LD) && (k >= STEP * fr) && (k <= STEP * fr + 128); \
                mx = fmaxf(mx, ok[T][r] ? s[T][r] : -1e30f); } \
        mx = fmaxf(mx, __shfl_xor(mx, 16)); mx = fmaxf(mx, __shfl_xor(mx, 32)); \
        const float m_new = fmaxf(m_run, mx), alpha = __builtin_amdgcn_exp2f(m_run - m_new); \
        float p[2][4], ps = 0.f; \
_Pragma("unroll") \
        for (int T = 0; T < 2; ++T) \
_Pragma("unroll") \
            for (int r = 0; r < 4; ++r) { p[T][r] = ok[T][r] ? __builtin_amdgcn_exp2f(s[T][r] - m_new) : 0.f; ps += p[T][r]; } \
        l_run = l_run * alpha + ps; m_run = m_new; \
_Pragma("unroll") \
        for (int dt = 0; dt < 4; ++dt) o[dt] = o[dt] * alpha; \
        u32x4v pw; pw.x = pkbf(p[0][0], p[0][1]); pw.y = pkbf(p[0][2], p[0][3]); pw.z = pkbf(p[1][0], p[1][1]); pw.w = pkbf(p[1][2], p[1][3]); \
        const bf16x8 pf = __builtin_bit_cast(bf16x8, pw); \
_Pragma("unroll") \
        for (int dt = 0; dt < 4; ++dt) { const s16x4 v0 = vtr(vrd + dt * 32), v1 = vtr(vrd + 16 * VROW + dt * 32); \
            const bf16x8 vf = (bf16x8){v0[0], v0[1], v0[2], v0[3], v1[0], v1[1], v1[2], v1[3]}; \
            o[dt] = __builtin_amdgcn_mfma_f32_16x16x32_bf16(vf, pf, o[dt], 0, 0, 0); } \
    } while (0)
#pragma unroll 1
    for (int c = 0; c < NC; c += 2) {
        if (c + 1 < NC) AB_LOAD(c + 1, 1);
        AB_COMPUTE(c, 0);
        if (c + 2 < NC) AB_LOAD(c + 2, 0);
        if (c + 1 < NC) AB_COMPUTE(c + 1, 1);
    }
#undef AB_COMPUTE
#undef AB_LOAD
}
__device__ __forceinline__ void unit(int b, int slot, int q0, const bf16_t* QB, const bf16_t* KB, const bf16_t* VB, bf16_t* OB, LAS char* lds, int wid, int lane) {
    LAS char* vl = lds + wid * WAVE_LDS;
    const size_t seq0 = (size_t)b * SEQ * PB;
    const int fr = lane & 15, fq = lane >> 4;
    for (int rs = 0; rs < 2; ++rs) {
        const int t0r = q0 + wid + 8 * rs;
        float m_run = -1e30f, l_run = 0.f; f32x4 o[4];
#pragma unroll
        for (int dt = 0; dt < 4; ++dt) o[dt] = (f32x4){0.f, 0.f, 0.f, 0.f};
        group<1>(QB + seq0 + 0 * 256 + slot * 64, KB + seq0 + 0 * 256 + slot * 64, VB + seq0 + 0 * 256 + slot * 64, t0r, vl, lane, m_run, l_run, o);
        group<4>(QB + seq0 + 1 * 256 + slot * 64, KB + seq0 + 1 * 256 + slot * 64, VB + seq0 + 1 * 256 + slot * 64, t0r, vl, lane, m_run, l_run, o);
        group<16>(QB + seq0 + 2 * 256 + slot * 64, KB + seq0 + 2 * 256 + slot * 64, VB + seq0 + 2 * 256 + slot * 64, t0r, vl, lane, m_run, l_run, o);
        float l = l_run; l += __shfl_xor(l, 16); l += __shfl_xor(l, 32);
        const float il = __builtin_amdgcn_rcpf(l);
        bf16_t* op = OB + ((size_t)b * SEQ + t0r + 16 * fr) * 256 + slot * 64 + 4 * fq;
#pragma unroll
        for (int dt = 0; dt < 4; ++dt) { const f32x4 v = o[dt] * il; u32x2 w; w.x = pkbf(v[0], v[1]); w.y = pkbf(v[2], v[3]); *(u32x2*)(op + 16 * dt) = w; }
    }
}
}

#define RLX_AGENT __ATOMIC_RELAXED, __HIP_MEMORY_SCOPE_AGENT
#define XB_TMO      128
#define XB_XCNT(j)  (256  + 64 * (j))
#define XB_XSUB(j)  (1280 + 64 * (j))
#define XB_XGEN(j)  (2304 + 64 * (j))
#define XB_TOP      3328
#define XB_TOPGEN   3392
#define XCD_BAR_WORDS 3456
#define XB_SPIN_CAP (1u << 18)

__device__ __forceinline__ unsigned xb_ld(unsigned* p)              { return __hip_atomic_load(p, __ATOMIC_RELAXED, __HIP_MEMORY_SCOPE_AGENT); }
__device__ __forceinline__ unsigned xb_add(unsigned* p, unsigned v) { return __hip_atomic_fetch_add(p, v, __ATOMIC_RELAXED, __HIP_MEMORY_SCOPE_AGENT); }
__device__ __forceinline__ unsigned xb_xcc_id() { return (unsigned)__builtin_amdgcn_s_getreg((3 << 11) | 20) & 0xFu; }
#define XB_SPIN(cond, bar) do { unsigned _sp = 0; while (cond) { __builtin_amdgcn_s_sleep(1); \
    if ((++_sp & 255u) == 0u) { if (xb_ld(&(bar)[XB_TMO])) break; if (_sp > XB_SPIN_CAP) { atomicAdd(&(bar)[XB_TMO], 1u); break; } } } } while (0)

struct XcdBarrier {
    unsigned* bar; unsigned x;
    volatile LAS unsigned* st;
};

__device__ __forceinline__ XcdBarrier xcd_barrier_post(unsigned* bar, volatile LAS unsigned* st) {
    XcdBarrier b; b.bar = bar; b.x = xb_xcc_id(); b.st = st;
    if (threadIdx.x == 0) (void)xb_add(&bar[XB_XCNT(b.x)], 1u);
    return b;
}
__device__ __forceinline__ void xcd_barrier_complete(unsigned* bar, unsigned x, unsigned& nloc, unsigned& nx) {
    const unsigned G = gridDim.x * gridDim.y * gridDim.z;
    unsigned sum, cnt, mine, sp = 0u;
    for (;;) {
        sum = 0u; cnt = 0u; mine = 0u;
#pragma unroll
        for (unsigned j = 0; j < 16; ++j) { const unsigned c = xb_ld(&bar[XB_XCNT(j)]); sum += c; cnt += (c > 0u) ? 1u : 0u; mine = (j == x) ? c : mine; }
        if (sum == G) break;
        __builtin_amdgcn_s_sleep(1);
        if ((++sp & 255u) == 0u) { if (xb_ld(&bar[XB_TMO])) break; if (sp > XB_SPIN_CAP) { atomicAdd(&bar[XB_TMO], 1u); break; } }
    }
    nloc = mine > 0u ? mine : 1u; nx = cnt > 0u ? cnt : 1u;
}

__device__ __forceinline__ void xcd_barrier(const XcdBarrier& b) {
    asm volatile("s_waitcnt vmcnt(0)" ::: "memory");
    __syncthreads();
    if (threadIdx.x == 0) {
        unsigned* bar = b.bar;
        __builtin_amdgcn_s_waitcnt(0);
        unsigned nloc = b.st[0], nx = b.st[1];
        if (nloc == 0u) { xcd_barrier_complete(bar, b.x, nloc, nx); b.st[0] = nloc; b.st[1] = nx; }
        const unsigned old = xb_add(&bar[XB_XSUB(b.x)], 1u);
        const unsigned gen = old / nloc;
        if (old + 1u == (gen + 1u) * nloc) {
            __builtin_amdgcn_fence(__ATOMIC_RELEASE, "agent");
            asm volatile("s_waitcnt vmcnt(0)" ::: "memory");
            const unsigned og = xb_add(&bar[XB_TOP], 1u);
            const unsigned tg = og / nx;
            if (og + 1u == (tg + 1u) * nx) xb_add(&bar[XB_TOPGEN], 1u);
            else XB_SPIN(xb_ld(&bar[XB_TOPGEN]) == tg, bar);
            __builtin_amdgcn_fence(__ATOMIC_ACQUIRE, "agent");
            xb_add(&bar[XB_XGEN(b.x)], 1u);
            asm volatile("s_waitcnt vmcnt(0)" ::: "memory");
        } else {
            XB_SPIN(xb_ld(&bar[XB_XGEN(b.x)]) == gen, bar);
            __builtin_amdgcn_fence(__ATOMIC_ACQUIRE, "agent");
            asm volatile("s_waitcnt vmcnt(0)" ::: "memory");
        }
    }
    __syncthreads();
}

struct Args { const float* in[18]; float* out; unsigned char* ws; int ph_lo, ph_hi; };
constexpr int NPHASE = 1 + 7 * DEPTH;

__device__ __forceinline__ float wave_sum(float v) {
#pragma unroll
    for (int o = 1; o < 64; o <<= 1) v += __shfl_xor(v, o);
    return v;
}
__device__ __forceinline__ void tr_item(const float* __restrict__ W, int ldn, int k0, int n0, bf16_t* __restrict__ dst, int dld, int prow0, int dk0, int ncopy, int dkstride, LAS float* scr, int lane, const float* __restrict__ kg = nullptr) {
#pragma unroll 8
    for (int i = 0; i < 32; ++i) { const int kk = 2 * i + (lane >> 5); float w = W[(size_t)(k0 + kk) * ldn + n0 + (lane & 31)]; if (kg) w *= kg[k0 + kk]; scr[kk * 33 + (lane & 31)] = w; }
    asm volatile("s_waitcnt lgkmcnt(0)" ::: "memory");
    const int c = lane & 7;
#pragma unroll
    for (int j = 0; j < 4; ++j) { const int n = (lane >> 3) + 8 * j; const LAS float* s = scr + (8 * c) * 33 + n;
        u32x4v o; o.x = pkbf(s[0 * 33], s[1 * 33]); o.y = pkbf(s[2 * 33], s[3 * 33]); o.z = pkbf(s[4 * 33], s[5 * 33]); o.w = pkbf(s[6 * 33], s[7 * 33]);
        for (int cp = 0; cp < ncopy; ++cp) *(u32x4v*)(dst + (size_t)(prow0 + n) * dld + dk0 + cp * dkstride + k0 + 8 * c) = o; }
    asm volatile("s_waitcnt lgkmcnt(0)" ::: "memory");
}

__global__ void __launch_bounds__(NWAVES * 64, 2) encoder_fwd(Args args) {
    extern __shared__ __attribute__((aligned(16))) unsigned char lds[];
    LAS unsigned char* L = (LAS unsigned char*)lds;
    const int G = gridDim.x, bx = blockIdx.x, vcu = (G % 8 == 0) ? (bx % 8) * (G / 8) + bx / 8 : bx;
    const int NGW = G * NWAVES;
    unsigned char* ws0 = args.ws;
    cg::grid_group grid = cg::this_grid();
    volatile LAS unsigned* bst = (volatile LAS unsigned*)(L + 131072 + 64);
    if (threadIdx.x < 2) bst[threadIdx.x] = 0u;
    __syncthreads();
    const XcdBarrier xbar = xcd_barrier_post((unsigned*)ws0, bst);

    for (int ph = args.ph_lo; ph < args.ph_hi; ++ph) {
        int tid_raw = threadIdx.x; asm volatile("" : "+v"(tid_raw));
        const int tid = tid_raw, lane = tid & 63, wid = __builtin_amdgcn_readfirstlane(tid >> 6), gw = vcu * NWAVES + wid; (void)tid;
            unsigned char* ws = ws0; asm volatile("" : "+s"(ws));
        bf16_t* Wall = (bf16_t*)(ws + WS_W);
        bf16_t* H = (bf16_t*)(ws + WS_H); bf16_t* QA = (bf16_t*)(ws + WS_QA); unsigned char* BIG = ws + WS_BIG;
        bf16_t* KA = (bf16_t*)(BIG + BIG_KA); bf16_t* VA = (bf16_t*)(BIG + BIG_VA); bf16_t* QB = (bf16_t*)(BIG + BIG_QB); bf16_t* KB = (bf16_t*)(BIG + BIG_KB);
        bf16_t* VB = (bf16_t*)(BIG + BIG_VB); bf16_t* UC = (bf16_t*)(BIG + BIG_UC); bf16_t* GT = (bf16_t*)BIG; bf16_t* ACT = (bf16_t*)BIG;
        bf16_t* OB = (bf16_t*)(ws + WS_OB); bf16_t* PC = (bf16_t*)(ws + WS_PC);
        bf16_t* XB1 = (bf16_t*)(ws + WS_QA); float* PSS1 = (float*)(ws + WS_PSS1); float* PSS2 = (float*)(ws + WS_PSS2);
        const float* xin = args.in[0]; float* xout = args.out;
        if (ph == 0) {
            LAS float* scr = (LAS float*)(L + wid * 16384);
            constexpr int I_IN = 16 * 208, I_A = 8 * 32, I_B = 4 * 32, I_O = 16 * 32, I_G = 16 * 88, I_D = 44 * 32, NIT = I_IN + I_A + I_B + I_O + 2 * I_G + I_D;
            for (int it = gw; it < DEPTH * NIT; it += NGW) {
                const int l = it / NIT; int r = it % NIT; bf16_t* Wl = Wall + (size_t)l * W_LAYER;
                if (r < I_IN) { const int kb = r / 208, nb = r % 208; tr_item(args.in[2] + (size_t)l * 1024 * INW, INW, 64 * kb, 32 * nb, Wl + W_IN, 1024, finv(32 * nb), 0, 1, 0, scr, lane, args.in[1] + l * DMODEL); continue; } r -= I_IN;
                if (r < I_A) { const int kb = r / 32, nb = r % 32; tr_item(args.in[10] + (size_t)l * 512 * 1024, 1024, 64 * kb, 32 * nb, Wl + W_A, 512, finv(32 * nb), 0, 1, 0, scr, lane); continue; } r -= I_A;
                if (r < I_B) { const int kb = r / 32, nb = r % 32; tr_item(args.in[11] + (size_t)l * 256 * 1024, 1024, 64 * kb, 32 * nb, Wl + W_B, 256, finv(32 * nb), 0, 1, 0, scr, lane); continue; } r -= I_B;
                if (r < I_O) { const int kb = r / 32, nb = r % 32; tr_item(args.in[13] + (size_t)l * 1024 * 1024, 1024, 64 * kb, 32 * nb, Wl + W_O3, 1024, finv(32 * nb), 0, 1, 0, scr, lane); continue; } r -= I_O;
                if (r < 2 * I_G) { const int up = r >= I_G; if (up) r -= I_G; const int kb = r / 88, nb = r % 88;
                    tr_item(args.in[up ? 16 : 15] + (size_t)l * 1024 * DFF, DFF, 64 * kb, 32 * nb, Wl + W_GU, 1024, finv(256 * (nb >> 2) + 64 * (nb & 3) + 32 * up), 0, 1, 0, scr, lane, args.in[14] + l * DMODEL); continue; } r -= 2 * I_G;
                { const int kb = r / 32, nb = r % 32; tr_item(args.in[17] + (size_t)l * DFF * 1024, 1024, 64 * kb, 32 * nb, Wl + W_D, DFF, finv(32 * nb), 0, 1, 0, scr, lane); }
            }
            for (int it = gw; it < DEPTH * 64 * 16; it += NGW) {
                const int l = it / 1024, c8 = (it >> 4) & 63, nb = it & 15, g = c8 >> 4, n = 64 * nb + lane;
                const float* lin = args.in[8] + ((size_t)l * 4 + g) * 128 * 128 + (size_t)((8 * c8) & 127) * 128;
                const float* sc = args.in[9] + l * 512 + 128 * g;
                const float* wc = args.in[12] + ((size_t)l * 512 + 128 * g) * 1024 + n;
                float a[8];
#pragma unroll
                for (int cc = 0; cc < 8; ++cc) a[cc] = 0.f;
                for (int d = 0; d < 128; ++d) { const float w = wc[(size_t)d * 1024] * sc[d];
#pragma unroll
                    for (int cc = 0; cc < 8; ++cc) a[cc] += lin[cc * 128 + d] * w; }
                u32x4v o; o.x = pkbf(a[0], a[1]); o.y = pkbf(a[2], a[3]); o.z = pkbf(a[4], a[5]); o.w = pkbf(a[6], a[7]);
                *(u32x4v*)(Wall + (size_t)l * W_LAYER + W_C + (size_t)finv(n) * 512 + 8 * c8) = o;
            }
            for (int m = gw; m < MTOK; m += NGW) {
                const f32x4* xr = (const f32x4*)(xin + (size_t)m * DMODEL) + lane; f32x4 v[4]; float sq = 0.f;
#pragma unroll
                for (int j = 0; j < 4; ++j) { v[j] = xr[64 * j]; sq += (v[j][0] * v[j][0] + v[j][1] * v[j][1]) + (v[j][2] * v[j][2] + v[j][3] * v[j][3]); }
                sq = wave_sum(sq);
                u32x2* o8 = (u32x2*)(H + (size_t)m * DMODEL) + lane;
#pragma unroll
                for (int j = 0; j < 4; ++j) { u32x2 w; w.x = pkbf(v[j][0], v[j][1]); w.y = pkbf(v[j][2], v[j][3]); o8[64 * j] = w; }
                if (lane < 16) PSS2[(size_t)m * 16 + lane] = (lane == 0) ? sq : 0.f;
            }
        } else {
            const int l = (ph - 1) / 7, sub = (ph - 1) % 7;
            const bf16_t* Wl = Wall + (size_t)l * W_LAYER;
            const float* xcur = (l == 0) ? xin : xout;
            if (sub == 0) {
#ifndef SKIP1
                pg8::Gemm g{H, Wl + W_IN, MTOK, 3584, 1024}; pg8::StaticOrder S; S.init(MTOK, 3584, G, bx);
                pg8::EpiInProj1 E{QA, KA, VA, QB, KB, VB, UC, args.in[4] + l * 64, args.in[5] + l * 64, args.in[6] + l * 64, args.in[7] + l * 64, PSS2};
                pg8::gemm_phase<pg8::EpiInProj1, pg8::StaticOrder, true, true>(L, g, S, E);
#endif
            } else if (sub == 1) {
#ifndef SKIP2A
                { const int per = (1024 + G - 1) / G;
                  for (int i = 0; i < per; ++i) { const int u = vcu * per + i; if (u >= 1024) break; const int bh = u >> 5, qb = u & 31, b = bh >> 3, h = bh & 7;
                      attn_body::attn_unit<8>(b, h, h >> 2, qb, (const attn_body::bf16*)QA, (const attn_body::bf16*)KA, (const attn_body::bf16*)VA, (attn_body::bf16*)QA, (char*)lds); } }
#endif
#ifndef SKIP2B
                { const int per = (512 + G - 1) / G;
                  for (int i = 0; i < per; ++i) { const int u = vcu * per + i; if (u >= 512) break; const int bs = u >> 5, qb = u & 31;
                      attnb::unit(bs >> 2, bs & 3, qb * 256, QB, KB, VB, OB, (LAS char*)L, wid, lane); } }
#endif
                for (int ch = gw; ch < MTOK / 16; ch += NGW) {
                    const int row0 = ch * 16, t0 = row0 & (SEQ - 1), hw = 1 << (lane >> 4);
                    const bf16_t* ub = UC + (size_t)(row0 - t0) * 512 + 8 * lane;
                    u32x4v u[31];
#pragma unroll
                    for (int i = 0; i < 31; ++i) { const int tt = t0 - 8 + i; const bool in = (tt >= 0) && (tt < SEQ); const u32x4v v = *(const u32x4v*)(ub + (size_t)(in ? tt : t0) * 512); u[i] = in ? v : (u32x4v){0u, 0u, 0u, 0u}; }
                    float mk[16];
#pragma unroll
                    for (int d = 0; d < 16; ++d) mk[d] = ((d - 8 >= -hw) && (d - 8 < hw)) ? 1.f : 0.f;
#pragma unroll
                    for (int jj = 0; jj < 16; ++jj) {
                        const int t = t0 + jj, lo = (t - hw < 0) ? 0 : t - hw, hi = (t + hw > SEQ) ? SEQ : t + hw; const float ic = 1.0f / (float)(hi - lo);
                        float sacc[8];
#pragma unroll
                        for (int k = 0; k < 8; ++k) sacc[k] = 0.f;
#pragma unroll
                        for (int d = 0; d < 16; ++d) { const u32x4v v = u[jj + d]; const float mm = mk[d];
                            sacc[0] += mm * bflo(v.x); sacc[1] += mm * bfhi(v.x); sacc[2] += mm * bflo(v.y); sacc[3] += mm * bfhi(v.y); sacc[4] += mm * bflo(v.z); sacc[5] += mm * bfhi(v.z); sacc[6] += mm * bflo(v.w); sacc[7] += mm * bfhi(v.w); }
                        const u32x4v sv = u[jj + 8]; u32x4v o;
                        o.x = pkbf(sacc[0] * ic - bflo(sv.x), sacc[1] * ic - bfhi(sv.x)); o.y = pkbf(sacc[2] * ic - bflo(sv.y), sacc[3] * ic - bfhi(sv.y));
                        o.z = pkbf(sacc[4] * ic - bflo(sv.z), sacc[5] * ic - bfhi(sv.z)); o.w = pkbf(sacc[6] * ic - bflo(sv.w), sacc[7] * ic - bfhi(sv.w));
                        *(u32x4v*)(PC + (size_t)(row0 + jj) * 512 + 8 * lane) = o;
                    }
                }
            } else if (sub == 2) {
                pg8::Gemm g{H, Wl + W_IN + (size_t)3584 * 1024, MTOK, GATEW, 1024}; pg8::StaticOrder S; S.init(MTOK, GATEW, G, bx);
                pg8::EpiGates E{GT, args.in[3] + l * GATEW, PSS2};

#ifndef SKIP3
pg8::gemm_phase<pg8::EpiGates, pg8::StaticOrder, true, true>(L, g, S, E);
#endif

            } else if (sub == 3) {
                pg8::StaticOrder S; S.init(MTOK, DMODEL, G, bx);
#ifndef SKIP4
#pragma unroll 1
                for (int br = 0; br < 3; ++br) {
                    const bf16_t* Ab = (br == 0) ? QA : ((br == 1) ? OB : PC); const bf16_t* Bw = Wl + ((br == 0) ? W_A : ((br == 1) ? W_B : W_C));
                    pg8::Gemm g{Ab, Bw, MTOK, DMODEL, (br == 1) ? 256 : 512}; pg8::EpiMerge E{GT, H, 1024 * br, br == 0};
                    pg8::gemm_phase<pg8::EpiMerge, pg8::StaticOrder, true, true>(L, g, S, E);
                }
#endif
            } else if (sub == 4) {
                pg8::Gemm g{H, Wl + W_O3, MTOK, DMODEL, 1024}; pg8::StaticOrder S; S.init(MTOK, DMODEL, G, bx);

#ifndef SKIP5
pg8::EpiRes E{xcur, xout, XB1, PSS1};
                pg8::gemm_phase<pg8::EpiRes, pg8::StaticOrder, true, true>(L, g, S, E);
#endif

            } else if (sub == 5) {
                pg8::Gemm g{XB1, Wl + W_GU, MTOK, 2 * DFF, 1024}; pg8::StaticOrder S; S.init(MTOK, 2 * DFF, G, bx);
                pg8::EpiFfn1 E{ACT, PSS1};

#ifndef SKIP7
pg8::gemm_phase<pg8::EpiFfn1, pg8::StaticOrder, true, true>(L, g, S, E);
#endif

            } else {
                pg8::Gemm g{ACT, Wl + W_D, MTOK, DMODEL, DFF}; pg8::StaticOrder S; S.init(MTOK, DMODEL, G, bx);

#ifndef SKIP8
pg8::EpiRes E{xout, xout, H, PSS2};
                pg8::gemm_phase<pg8::EpiRes, pg8::StaticOrder, true, true>(L, g, S, E);
#endif

            }
        }
        if (ph + 1 < args.ph_hi) { if (ph == args.ph_lo) grid.sync(); else xcd_barrier(xbar); }
    }
}

__global__ void dbg_dump(const unsigned short* src, float* out, size_t n) {
    for (size_t i = (size_t)blockIdx.x * blockDim.x + threadIdx.x; i < n; i += (size_t)gridDim.x * blockDim.x) out[i] = bf2f(src[i]);
}
#ifndef MK_ONE_LAUNCH
#define MK_ONE_LAUNCH 1
#endif
extern "C" void kernel_launch(void* const* d_in, const int* in_sizes, int n_in, void* d_out, int out_size, void* d_ws, size_t ws_size, hipStream_t stream) {
    static int grid = 0;
    if (grid == 0) {
        int dev = 0, cus = 0, per_cu = 0;
        if (n_in != 18 || out_size != MTOK * DMODEL || ws_size < WS_END) { fprintf(stderr, "kernel_launch: unexpected shapes (n_in %d out %d ws %zu)\n", n_in, out_size, ws_size); grid = -1; return; }
        if (hipGetDevice(&dev) != hipSuccess || hipDeviceGetAttribute(&cus, hipDeviceAttributeMultiprocessorCount, dev) != hipSuccess) { grid = -1; return; }
        if (hipFuncSetAttribute((const void*)encoder_fwd, hipFuncAttributeMaxDynamicSharedMemorySize, LDS_BYTES) != hipSuccess) { fprintf(stderr, "kernel_launch: hipFuncSetAttribute failed\n"); grid = -1; return; }
        if (hipOccupancyMaxActiveBlocksPerMultiprocessor(&per_cu, (const void*)encoder_fwd, NWAVES * 64, LDS_BYTES) != hipSuccess || per_cu < 1) per_cu = 1;
        (void)hipGetLastError();
        grid = cus * per_cu;
    }
    if (grid < 0) return;
    Args a{};
    for (int i = 0; i < 18; ++i) a.in[i] = (const float*)d_in[i];
    a.out = (float*)d_out; a.ws = (unsigned char*)d_ws;
#if MK_ONE_LAUNCH
    (void)hipMemsetAsync(d_ws, 0, 16384, stream);
    a.ph_lo = 0; a.ph_hi = NPHASE;
    void* kargs[] = {&a};
    hipError_t e = hipLaunchCooperativeKernel((const void*)encoder_fwd, dim3(grid), dim3(NWAVES * 64), kargs, LDS_BYTES, stream);
    if (e != hipSuccess) fprintf(stderr, "kernel_launch: cooperative launch failed: %s (grid %d)\n", hipGetErrorString(e), grid);
#else
#ifdef DBG_STOP
    for (int ph = 0; ph < DBG_STOP; ++ph) {
        a.ph_lo = ph; a.ph_hi = ph + 1;
        hipLaunchKernelGGL(encoder_fwd, dim3(grid), dim3(NWAVES * 64), LDS_BYTES, stream, a);
    }
    hipLaunchKernelGGL(dbg_dump, dim3(1024), dim3(256), 0, stream, (const unsigned short*)((unsigned char*)d_ws + DBG_OFF), (float*)d_out, (size_t)MTOK * DMODEL);
#else
    for (int ph = 0; ph < NPHASE; ++ph) {
        a.ph_lo = ph; a.ph_hi = ph + 1;
        hipLaunchKernelGGL(encoder_fwd, dim3(grid), dim3(NWAVES * 64), LDS_BYTES, stream, a);
    }
#endif
#endif
}
```

```cpp
#include <hip/hip_runtime.h>
#include <hip/hip_cooperative_groups.h>
#include <cstdio>
#include <cstdint>
namespace cg = cooperative_groups;
namespace pg8 {
#define PG8_LAS __attribute__((address_space(3)))
typedef unsigned short bf16_t;
typedef short bf16x8 __attribute__((ext_vector_type(8)));
typedef float f32x4 __attribute__((ext_vector_type(4)));
typedef unsigned u32x4 __attribute__((ext_vector_type(4)));
constexpr int BM = 256, BK = 64, HALF = 128, HTB = HALF * BK * 2  , STAGE_BYTES = 8 * HTB, NXCD = 8, WGM = 8;

__host__ __device__ __forceinline__ int lds_byte(int r, int c) { const int st = (r >> 4) * 2 + (c >> 5), rr = r & 15, cc = c & 31, ob = rr * 64 + cc * 2; return st * 1024 + (ob ^ (((ob >> 9) & 1) << 5)); }
__host__ __device__ __forceinline__ void stage_rc(int b, int& R, int& C) { const int st = b / 1024, sb = b % 1024, swz = sb ^ (((sb >> 9) & 1) << 5); R = (st >> 1) * 16 + swz / 64; C = (st & 1) * 32 + (swz % 64) / 2; }
__host__ __device__ __forceinline__ int perm32(int rho) { const int n = rho >> 4, i = rho & 15; return 8 * (i >> 2) + 4 * n + (i & 3); }

struct Unit { int pm, pn; };
struct Gemm { const bf16_t* A; const bf16_t* Bt; int M, N, K; };

struct StaticOrder {
    int nM, nN, nwg, G, c;
    __host__ __device__ void init(int M, int N, int G_, int c_) { nM = M / BM; nN = N / BM; nwg = nM * nN; G = G_; c = c_; }
    __host__ __device__ bool next(int i, Unit& u) const {
        const long L = (long)i * G + c; if (L >= nwg) return false;
        int wgid = (int)L; { const int q = nwg / NXCD, r = nwg % NXCD, xcd = wgid % NXCD, off = wgid / NXCD; wgid = (xcd < r ? xcd * (q + 1) : r * (q + 1) + (xcd - r) * q) + off; }
        const int nig = WGM * nN, gid = wgid / nig, fm = gid * WGM, gsz = (nM - fm) < WGM ? (nM - fm) : WGM;
        u.pm = fm + ((wgid % nig) % gsz); u.pn = (wgid % nig) / gsz; return true;
    }
    __device__ __forceinline__ void a_ready(const Unit&) const {}
    __device__ __forceinline__ void done(const Unit&) const {}
};

typedef float f32x2c __attribute__((ext_vector_type(2))); typedef __bf16 bf16x2c __attribute__((ext_vector_type(2)));
__device__ __forceinline__ unsigned cvt_pk_bf16(float lo, float hi) { f32x2c v = {lo, hi}; bf16x2c b = __builtin_convertvector(v, bf16x2c); return __builtin_bit_cast(unsigned, b); }
typedef float f32x2 __attribute__((ext_vector_type(2)));
template <class Epi, class Sched, bool ALIGN_EPI = false, bool SP2 = false>
__device__ __forceinline__ void gemm_phase(PG8_LAS unsigned char* lds, const Gemm g, const Sched& S, const Epi& E) {
    int tid_raw = threadIdx.x; asm volatile("" : "+v"(tid_raw));
    const int tid = tid_raw, wid = __builtin_amdgcn_readfirstlane(tid >> 6), lane = tid & 63, wr = wid >> 2, wc = wid & 3, fr = lane & 15, fq = lane >> 4;
    const int K = g.K, nt = K / BK;
    unsigned voffA[2], voffB[2];
#pragma unroll
    for (int i = 0; i < 2; ++i) { int R, C; stage_rc(tid * 16 + i * 8192, R, C); const int Rb = Epi::PERM ? ((R & ~31) + perm32(R & 31)) : R;
        voffA[i] = (unsigned)(R * K + C) * 2u; voffB[i] = (unsigned)(Rb * K + C) * 2u; }
    const size_t kstep = (size_t)(BK * 2);
    const size_t hstep = (size_t)HALF * K * 2;
    const size_t tstep = 2 * hstep;
    const unsigned ldsw = (unsigned)wid * 1024u;
    const int aoff = lds_byte(wr * 64 + fr, fq * 8), boff = lds_byte(wc * 32 + fr, fq * 8);
#define PG8_SA(b, h) (((b) * 2 + (h)) * HTB)
#define PG8_SB(b, h) ((4 + (b) * 2 + (h)) * HTB)
#define PG8_STAGE(bufoff, gbase, voff) do { _Pragma("unroll") for (int _i = 0; _i < 2; ++_i) \
        __builtin_amdgcn_global_load_lds((const unsigned*)((const char*)(gbase) + (voff)[_i]), (PG8_LAS unsigned*)(lds + (bufoff) + ldsw + _i * 8192), 16, 0, 0); } while (0)
#define PG8_LDA(dst, b, h) do { _Pragma("unroll") for (int m = 0; m < 4; ++m) _Pragma("unroll") for (int k = 0; k < 2; ++k) dst[m][k] = *(const PG8_LAS bf16x8*)(lds + PG8_SA(b, h) + aoff + m * 2048 + k * 1024); } while (0)
#define PG8_LDB(dst, b, h) do { _Pragma("unroll") for (int n = 0; n < 2; ++n) _Pragma("unroll") for (int k = 0; k < 2; ++k) dst[n][k] = *(const PG8_LAS bf16x8*)(lds + PG8_SB(b, h) + boff + n * 2048 + k * 1024); } while (0)
#define PG8_MMA(ai, bj, At, Bt) do { __builtin_amdgcn_s_setprio(1); _Pragma("unroll") for (int m = 0; m < 4; ++m) _Pragma("unroll") for (int n = 0; n < 2; ++n) _Pragma("unroll") for (int k = 0; k < 2; ++k) \
        acc[ai][bj][m][n] = __builtin_amdgcn_mfma_f32_16x16x32_bf16(Bt[n][k], At[m][k], acc[ai][bj][m][n], 0, 0, 0); __builtin_amdgcn_s_setprio(0); } while (0)
#define PG8_WAIT_V(n) asm volatile("s_waitcnt vmcnt(" #n ")" ::: "memory")
#define PG8_WAIT_L(n) asm volatile("s_waitcnt lgkmcnt(" #n ")" ::: "memory")
#define PG8_BAR __builtin_amdgcn_s_barrier()
#define PG8_SCHED __builtin_amdgcn_sched_barrier(0)
    Unit cur, nxt; int ui = 0;
    if (!S.next(0, cur)) return;
    f32x4 acc[2][2][4][2];
#pragma unroll
    for (int a = 0; a < 2; ++a)
#pragma unroll
        for (int b = 0; b < 2; ++b)
#pragma unroll
            for (int m = 0; m < 4; ++m)
#pragma unroll
                for (int n = 0; n < 2; ++n) acc[a][b][m][n] = (f32x4){0.f, 0.f, 0.f, 0.f};
    bf16x8 At[4][2], B0[2][2], B1[2][2];
    const char* cA = (const char*)g.A + (size_t)cur.pm * tstep; const char* cB = (const char*)g.Bt + (size_t)cur.pn * tstep;
    S.a_ready(cur);
    if constexpr (SP2) {
        PG8_STAGE(PG8_SB(0, 0), cB, voffB); PG8_STAGE(PG8_SB(0, 1), cB + hstep, voffB); PG8_STAGE(PG8_SA(0, 0), cA, voffA); PG8_STAGE(PG8_SA(0, 1), cA + hstep, voffA);
        if (wr == 1) PG8_BAR;
        PG8_WAIT_V(2); PG8_BAR;
        PG8_STAGE(PG8_SB(1, 0), cB + kstep, voffB); PG8_STAGE(PG8_SA(1, 0), cA + kstep, voffA); PG8_STAGE(PG8_SB(1, 1), cB + hstep + kstep, voffB);
        PG8_WAIT_V(6); PG8_BAR;
    } else {
        PG8_STAGE(PG8_SB(0, 0), cB, voffB); PG8_STAGE(PG8_SA(0, 0), cA, voffA); PG8_STAGE(PG8_SB(0, 1), cB + hstep, voffB); PG8_STAGE(PG8_SA(0, 1), cA + hstep, voffA);
        if (wr == 1) PG8_BAR;
        PG8_WAIT_V(4); PG8_BAR;
        PG8_STAGE(PG8_SB(1, 0), cB + kstep, voffB); PG8_STAGE(PG8_SA(1, 0), cA + kstep, voffA); PG8_STAGE(PG8_SB(1, 1), cB + hstep + kstep, voffB);
        PG8_WAIT_V(6); PG8_BAR;
    }
    for (;;) {
        const bool has_next = S.next(ui + 1, nxt);
        const char* nA = has_next ? (const char*)g.A + (size_t)nxt.pm * tstep : cA; const char* nB = has_next ? (const char*)g.Bt + (size_t)nxt.pn * tstep : cB;
        for (int t = 0; t < nt; t += 2) {
            const bool last = (t == nt - 2);
            const char* a1 = cA + (size_t)(t + 1) * kstep;
            const char* a2 = last ? nA : cA + (size_t)(t + 2) * kstep; const char* b2 = last ? nB : cB + (size_t)(t + 2) * kstep;
            const char* a3 = a2 + kstep; const char* b3 = b2 + kstep;
            if (last && has_next) S.a_ready(nxt);
            if constexpr (SP2) {
            PG8_LDB(B0, 0, 0); PG8_LDB(B1, 0, 1); PG8_SCHED; PG8_LDA(At, 0, 0); PG8_STAGE(PG8_SA(1, 1), a1 + hstep, voffA);
            PG8_WAIT_V(8); PG8_WAIT_L(0); PG8_BAR; PG8_MMA(0, 0, At, B0); PG8_MMA(0, 1, At, B1); PG8_BAR; PG8_SCHED;
            PG8_LDA(At, 0, 1); PG8_STAGE(PG8_SB(0, 0), b2, voffB); PG8_STAGE(PG8_SB(0, 1), b2 + hstep, voffB); PG8_STAGE(PG8_SA(0, 0), a2, voffA);
            PG8_WAIT_V(8); PG8_WAIT_L(0); PG8_BAR; PG8_MMA(1, 0, At, B0); PG8_MMA(1, 1, At, B1); PG8_BAR; PG8_SCHED;
            PG8_LDB(B0, 1, 0); PG8_LDB(B1, 1, 1); PG8_SCHED; PG8_LDA(At, 1, 0); PG8_STAGE(PG8_SA(0, 1), a2 + hstep, voffA);
            PG8_WAIT_V(8); PG8_WAIT_L(0); PG8_BAR; PG8_MMA(0, 0, At, B0); PG8_MMA(0, 1, At, B1); PG8_BAR; PG8_SCHED;
            PG8_LDA(At, 1, 1); PG8_STAGE(PG8_SB(1, 0), b3, voffB); PG8_STAGE(PG8_SB(1, 1), b3 + hstep, voffB); PG8_STAGE(PG8_SA(1, 0), a3, voffA);
            PG8_WAIT_V(8); PG8_WAIT_L(0); PG8_BAR; PG8_MMA(1, 0, At, B0); PG8_MMA(1, 1, At, B1); PG8_BAR; PG8_SCHED;
            } else {
            PG8_LDB(B0, 0, 0); PG8_SCHED; PG8_LDA(At, 0, 0); PG8_STAGE(PG8_SA(1, 1), a1 + hstep, voffA);
            PG8_WAIT_L(8); PG8_BAR; PG8_WAIT_L(0); PG8_MMA(0, 0, At, B0); PG8_BAR; PG8_SCHED;
            PG8_LDB(B1, 0, 1); PG8_STAGE(PG8_SB(0, 0), b2, voffB);
            PG8_BAR; PG8_WAIT_L(0); PG8_MMA(0, 1, At, B1); PG8_BAR;
            PG8_LDA(At, 0, 1); PG8_STAGE(PG8_SA(0, 0), a2, voffA);
            PG8_BAR; PG8_WAIT_L(0); PG8_MMA(1, 0, At, B0); PG8_BAR; PG8_SCHED;
            PG8_STAGE(PG8_SB(0, 1), b2 + hstep, voffB);
            PG8_WAIT_V(6); PG8_BAR; PG8_MMA(1, 1, At, B1); PG8_BAR;
            PG8_LDB(B0, 1, 0); PG8_SCHED; PG8_LDA(At, 1, 0); PG8_STAGE(PG8_SA(0, 1), a2 + hstep, voffA);
            PG8_WAIT_L(8); PG8_BAR; PG8_WAIT_L(0); PG8_MMA(0, 0, At, B0); PG8_BAR; PG8_SCHED;
            PG8_LDB(B1, 1, 1); PG8_STAGE(PG8_SB(1, 0), b3, voffB);
            PG8_BAR; PG8_WAIT_L(0); PG8_MMA(0, 1, At, B1); PG8_BAR;
            PG8_LDA(At, 1, 1); PG8_STAGE(PG8_SA(1, 0), a3, voffA);
            PG8_BAR; PG8_WAIT_L(0); PG8_MMA(1, 0, At, B0); PG8_BAR; PG8_SCHED;
            PG8_STAGE(PG8_SB(1, 1), b3 + hstep, voffB);
            PG8_WAIT_V(6); PG8_BAR; PG8_MMA(1, 1, At, B1); PG8_BAR;
            }
        }
        if constexpr (ALIGN_EPI) { if (wr == 0) PG8_BAR; }
        if constexpr (!Epi::AFTER_DRAIN) { E(acc, cur, wr, wc, fr, fq); S.done(cur); }
        if (!has_next) break;
#pragma unroll
        for (int a = 0; a < 2; ++a)
#pragma unroll
            for (int b = 0; b < 2; ++b)
#pragma unroll
                for (int m = 0; m < 4; ++m)
#pragma unroll
                    for (int n = 0; n < 2; ++n) acc[a][b][m][n] = (f32x4){0.f, 0.f, 0.f, 0.f};
        cur = nxt; cA = nA; cB = nB; ++ui;
        if constexpr (ALIGN_EPI) { if (wr == 1) PG8_BAR; }
    }
    PG8_WAIT_V(0);
    if constexpr (!ALIGN_EPI) { if (wr == 0) PG8_BAR; }
    PG8_BAR;
    if constexpr (Epi::AFTER_DRAIN) { E.fused(acc, cur, wr, wc, fr, fq, lds, wid, lane); S.done(cur); }
#undef PG8_SA
#undef PG8_SB
#undef PG8_STAGE
#undef PG8_LDA
#undef PG8_LDB
#undef PG8_MMA
#undef PG8_WAIT_V
#undef PG8_WAIT_L
#undef PG8_BAR
#undef PG8_SCHED
}
}
#include <hip/hip_bf16.h>
#include <cmath>
namespace attn_body {
using bf16=__hip_bfloat16;
using bf16x8=__attribute__((ext_vector_type(8)))short;
using s16x4=__attribute__((ext_vector_type(4)))short;
using f32x16=__attribute__((ext_vector_type(16)))float;
using u32x4=__attribute__((ext_vector_type(4)))unsigned;
constexpr int SEQ=8192,D=64,PQ=512,PKV=128;
constexpr int NW=8,QBLK=32,QB=QBLK*NW,KVBLK=64,NQB=SEQ/QB;
constexpr int ATTN_UNIT_ROWS=QB;
__device__ __forceinline__ int crow(int r,int hi){return (r&3)+8*(r>>2)+4*hi;}
#define SBAR() __builtin_amdgcn_sched_barrier(0)
__device__ __forceinline__ void cmask(f32x16&p0,f32x16&p1,int jb,int qrel,int hi){
  const float NEG=-INFINITY; int kb=64*jb+4*hi;
  #pragma unroll
  for(int r=0;r<16;++r){int kv=kb+(r&3)+8*(r>>2); if(kv>qrel)p0[r]=NEG; if(kv+32>qrel)p1[r]=NEG;}
}

constexpr int NSLOT=3, SLOTB=8192;
constexpr int LDS_K=0, LDS_V=NSLOT*SLOTB, LDS_WS=2*NSLOT*SLOTB, LDS_OST=LDS_WS+NW*64*4, LDS_BYTES=LDS_OST+NW*4096;
constexpr float C2=0.125f*1.4426950408889634f;
__device__ __forceinline__ void glds16(const void*gsrc,unsigned lds_dst){unsigned keep;
  asm volatile("s_mov_b32 %0, m0\n\ts_mov_b32 m0, %2\n\ts_nop 0\n\tglobal_load_lds_dwordx4 %1, off\n\ts_mov_b32 m0, %0":"=&s"(keep):"v"(gsrc),"s"(lds_dst):"memory");}
__device__ __forceinline__ float max3f(float a,float b,float c){float r;asm("v_max3_f32 %0, %1, %2, %3":"=v"(r):"v"(a),"v"(b),"v"(c));return r;}
__device__ __forceinline__ float max2f(float a,float b){float r;asm("v_max_f32_e32 %0, %1, %2":"=v"(r):"v"(a),"v"(b));return r;}
__device__ __forceinline__ float fadd_s(float a,float b){float r;asm("v_add_f32_e32 %0, %1, %2":"=v"(r):"v"(a),"v"(b));return r;}
__device__ __forceinline__ float fsub_s(float a,float b){float r;asm("v_sub_f32_e32 %0, %1, %2":"=v"(r):"v"(a),"v"(b));return r;}
typedef float f32x2_t __attribute__((ext_vector_type(2))); typedef __bf16 bf16x2_t __attribute__((ext_vector_type(2)));
__device__ __forceinline__ unsigned cvtpk_s(float lo,float hi){f32x2_t v={lo,hi};bf16x2_t b=__builtin_convertvector(v,bf16x2_t);return __builtin_bit_cast(unsigned,b);}
#define WAIT_BAR(N) asm volatile("s_waitcnt vmcnt(" #N ") lgkmcnt(0)\n\ts_barrier":::"memory")

__device__ __forceinline__ void qkt(f32x16&p0,f32x16&p1,const char*Kslot,const bf16x8*qr,const f32x16&negm,int r32,int hi){
  const char*kb=Kslot+hi*1024+r32*16;
  #pragma unroll
  for(int d0=0;d0<4;++d0){
    const bf16x8 b0=*reinterpret_cast<const bf16x8*>(kb+d0*2048);
    const bf16x8 b1=*reinterpret_cast<const bf16x8*>(kb+d0*2048+512);
    if(d0==0){p0=__builtin_amdgcn_mfma_f32_32x32x16_bf16(b0,qr[0],negm,0,0,0);p1=__builtin_amdgcn_mfma_f32_32x32x16_bf16(b1,qr[0],negm,0,0,0);}
    else{p0=__builtin_amdgcn_mfma_f32_32x32x16_bf16(b0,qr[d0],p0,0,0,0);p1=__builtin_amdgcn_mfma_f32_32x32x16_bf16(b1,qr[d0],p1,0,0,0);}}
}
typedef __attribute__((address_space(3))) const char* lds_cptr;
typedef short v4i16_t __attribute__((ext_vector_type(4)));
__device__ __forceinline__ void kload8(bf16x8*kf,lds_cptr kp){
  kf[0]=*(const __attribute__((address_space(3))) bf16x8*)(kp);      kf[1]=*(const __attribute__((address_space(3))) bf16x8*)(kp+512);
  kf[2]=*(const __attribute__((address_space(3))) bf16x8*)(kp+2048); kf[3]=*(const __attribute__((address_space(3))) bf16x8*)(kp+2560);
  kf[4]=*(const __attribute__((address_space(3))) bf16x8*)(kp+4096); kf[5]=*(const __attribute__((address_space(3))) bf16x8*)(kp+4608);
  kf[6]=*(const __attribute__((address_space(3))) bf16x8*)(kp+6144); kf[7]=*(const __attribute__((address_space(3))) bf16x8*)(kp+6656);
}
__device__ __forceinline__ void kload2(bf16x8*kf,lds_cptr kp,int j){ kf[2*j]=*(const __attribute__((address_space(3))) bf16x8*)(kp+j*2048); kf[2*j+1]=*(const __attribute__((address_space(3))) bf16x8*)(kp+j*2048+512); }
__device__ __forceinline__ s16x4 vtr(lds_cptr p){ return __builtin_bit_cast(s16x4,__builtin_amdgcn_ds_read_tr16_b64_v4i16((__attribute__((address_space(3))) v4i16_t*)p)); }
__device__ __forceinline__ float rowmax(const f32x16&p0,const f32x16&p1){
  float a=max3f(p0[0],p0[1],p1[0]),b=max3f(p0[2],p0[3],p1[1]);a=max3f(a,p1[2],p1[3]);
  #pragma unroll
  for(int r=4;r<16;r+=4){a=max3f(a,p0[r],p0[r+1]);b=max3f(b,p0[r+2],p0[r+3]);a=max3f(a,p1[r],p1[r+1]);b=max3f(b,p1[r+2],p1[r+3]);}
  const float m=max2f(a,b);
  auto rr=__builtin_amdgcn_permlane32_swap(__float_as_uint(m),__float_as_uint(m),false,false);
  return max2f(__uint_as_float(rr[0]),__uint_as_float(rr[1]));
}
__device__ __forceinline__ void pv(f32x16*o,int vb,bf16x8 pa0,bf16x8 pa1,bf16x8 pa2,bf16x8 pa3){
  #pragma unroll
  for(int d0=0;d0<2;++d0){s16x4 lo[4],hi[4];
    #pragma unroll
    for(int ks=0;ks<4;++ks){
      asm volatile("ds_read_b64_tr_b16 %0,%1 offset:%c2":"=&v"(lo[ks]):"v"(vb),"i"(d0*4096+ks*1024):"memory");
      asm volatile("ds_read_b64_tr_b16 %0,%1 offset:%c2":"=&v"(hi[ks]):"v"(vb),"i"(d0*4096+ks*1024+512):"memory");}
    asm volatile("s_waitcnt lgkmcnt(0)":::"memory");SBAR();
    #define PK(k) (bf16x8){lo[k][0],lo[k][1],lo[k][2],lo[k][3],hi[k][0],hi[k][1],hi[k][2],hi[k][3]}
    o[d0]=__builtin_amdgcn_mfma_f32_32x32x16_bf16(pa0,PK(0),o[d0],0,0,0);
    o[d0]=__builtin_amdgcn_mfma_f32_32x32x16_bf16(pa1,PK(1),o[d0],0,0,0);
    o[d0]=__builtin_amdgcn_mfma_f32_32x32x16_bf16(pa2,PK(2),o[d0],0,0,0);
    o[d0]=__builtin_amdgcn_mfma_f32_32x32x16_bf16(pa3,PK(3),o[d0],0,0,0);
    #undef PK
  }
}

#ifndef ATTN_STORE16
#define ATTN_STORE16(p,v) (*(u32x4*)(p)=(v))
#endif
template<int THRL> __device__ __forceinline__ void attn_unit(int b,int h,int kvh,int qb,const bf16*Q,const bf16*__restrict__ K,const bf16*__restrict__ V,bf16*O,char*shm){
  int tid_raw=threadIdx.x; asm volatile("":"+v"(tid_raw));
  const int tid=tid_raw,lane=tid&63,r32=lane&31,hi=lane>>5; const int wid=__builtin_amdgcn_readfirstlane(tid>>6);
  const long rowbase=(long)b*SEQ; const int q0=qb*QB;
  const bf16*Qw=Q+(rowbase+q0+wid*QBLK)*PQ+h*D;
  const bf16*Kh=K+rowbase*PKV+kvh*D,*Vh=V+rowbase*PKV+kvh*D;
  const unsigned lds0=(unsigned)(uintptr_t)shm;
  float*wsf=(float*)(shm+LDS_WS)+wid*64;
  const bf16*ksrc=Kh+(long)lane*PKV+wid*8;
  const bf16*vsrc=Vh+(long)(16*(wid&3)+(lane>>2))*PKV+(wid>>2)*32+(lane&3)*8;
  const unsigned kdst=lds0+LDS_K+wid*1024, vdst=lds0+LDS_V+wid*1024;
  #define DMA_K(t,slot) glds16(ksrc+(long)(t)*KVBLK*PKV,(unsigned)__builtin_amdgcn_readfirstlane(kdst+(slot)))
  #define DMA_V(t,slot) glds16(vsrc+(long)(t)*KVBLK*PKV,(unsigned)__builtin_amdgcn_readfirstlane(vdst+(slot)))
  const int vb0=(int)(lds0+LDS_V)+((lane>>4)&1)*32+(lane&3)*8+(4*hi+((lane&15)>>2))*64;
  const char*Kbase=shm+LDS_K; bf16x8 kf[8];
  const lds_cptr shm3=(lds_cptr)shm; const lds_cptr kp0=shm3+LDS_K+hi*1024+r32*16; const lds_cptr vp0=shm3+LDS_V+((lane>>4)&1)*32+(lane&3)*8+(4*hi+((lane&15)>>2))*64;
  const int NT=SEQ/KVBLK;
  DMA_K(0,0);DMA_V(0,0);DMA_K(1,SLOTB);
  bf16x8 qr[4];
  #pragma unroll
  for(int d0=0;d0<4;++d0)qr[d0]=*reinterpret_cast<const bf16x8*>(&Qw[(long)r32*PQ+d0*16+hi*8]);
  float mhat=0.f,l_reg=0.f;f32x16 o[2];o[0]=f32x16{};o[1]=f32x16{};f32x16 negm=f32x16{};asm volatile("":"+v"(negm));
  const int qrel=wid*QBLK+r32;
  #define CMASK(P0,P1,t) do{}while(0)
  bool resc=false;
  #define START(P0,P1) do{ const float rm=rowmax(P0,P1); resc=false; \
    { const float dl=rm; mhat=fadd_s(mhat,dl); \
      _Pragma("unroll") for(int r=0;r<16;++r){P0[r]=fsub_s(P0[r],dl);P1[r]=fsub_s(P1[r],dl);} \
      _Pragma("unroll") for(int r=0;r<16;++r)negm[r]=-mhat; asm volatile("":"+v"(negm)); } \
    _Pragma("unroll") for(int r=0;r<16;++r)P0[r]=__builtin_amdgcn_exp2f(P0[r]); }while(0)
  #define RESC() do{ if(resc){ asm volatile("s_waitcnt lgkmcnt(0)":::"memory"); \
      _Pragma("unroll") for(int d_=0;d_<2;++d_) _Pragma("unroll") for(int r=0;r<16;++r)o[d_][r]*=wsf[crow(r,hi)]; } }while(0)
  f32x16 pA0,pA1,pB0,pB1;
  int sl_prev=0,sl_cur=0,sl_next=SLOTB;
  #define ROT() do{sl_prev=sl_cur;sl_cur=sl_next;sl_next=(sl_next==(NSLOT-1)*SLOTB)?0:sl_next+SLOTB;}while(0)
  DMA_K(2,2*SLOTB);
  WAIT_BAR(3);
  qkt(pA0,pA1,Kbase,qr,negm,r32,hi);asm volatile("s_nop 15\n\ts_nop 7":"+v"(pA0),"+v"(pA1));CMASK(pA0,pA1,0);
  START(pA0,pA1);
  _Pragma("unroll") for(int r=0;r<16;++r)pA1[r]=__builtin_amdgcn_exp2f(pA1[r]);
  WAIT_BAR(0);
  DMA_K(3,0);DMA_V(1,SLOTB);
  ROT();
  kload8(kf,kp0+sl_cur);
  WAIT_BAR(2);
  s16x4 vlo[8],vhi[8]; u32x4 pw0,pw1,pw2,pw3;
  #define PKW(P,B) cvtpk_s(P[B],P[B+1])
  #define PAF(k) __builtin_bit_cast(bf16x8,pw##k)
  #define VFR(i) (bf16x8){vlo[i][0],vlo[i][1],vlo[i][2],vlo[i][3],vhi[i][0],vhi[i][1],vhi[i][2],vhi[i][3]}
  #define PIN(x) asm volatile("":"+v"(x))
  #define MX3(a,b,c) __builtin_fmaxf(__builtin_fmaxf((a),(b)),(c))
  #define GAPA(MF,A0,A1,A2,A3,W0,W1,PW) do{ MF; sacc+=A0; sacc+=A1; sacc+=A2; sacc+=A3; PIN(sacc); W0; W1; PIN(PW); SBAR(); }while(0)
  #define EX(v) __builtin_amdgcn_exp2f(v)
  #define GAPB(MF,X,B) do{ MF; X[B]=EX(X[B]); X[B+1]=EX(X[B+1]); X[B+2]=EX(X[B+2]); X[B+3]=EX(X[B+3]); PIN(X); SBAR(); }while(0)
  #define VRD(i) do{ vlo[i]=vtr(vp_+(((i)>>2)*4096+((i)&3)*1024)); vhi[i]=vtr(vp_+(((i)>>2)*4096+((i)&3)*1024+512)); }while(0)
  #define KRD(G,j) do{ if(G){ kload2(kf,kp0+sl_next,j); SBAR(); } }while(0)
  #define STEP(C0,C1,P0,P1,t,GK,GV,GL) do{ SBAR(); \
    const lds_cptr vp_=vp0+sl_prev; \
    VRD(0); SBAR(); float sacc=(P0[0]+P0[1]); \
    GAPA(C0=__builtin_amdgcn_mfma_f32_32x32x16_bf16(kf[0],qr[0],negm,0,0,0), P0[2],P0[3],P0[4],P0[5],     pw0[0]=PKW(P0,0), pw0[1]=PKW(P0,2), pw0); \
    VRD(4); SBAR(); GAPA(C1=__builtin_amdgcn_mfma_f32_32x32x16_bf16(kf[1],qr[0],negm,0,0,0), P0[6],P0[7],P0[8],P0[9],     pw0[2]=PKW(P0,4), pw0[3]=PKW(P0,6), pw0); \
    VRD(1); SBAR(); GAPA(C0=__builtin_amdgcn_mfma_f32_32x32x16_bf16(kf[2],qr[1],C0,0,0,0),   P0[10],P0[11],P0[12],P0[13], pw1[0]=PKW(P0,8), pw1[1]=PKW(P0,10), pw1); \
    VRD(5); SBAR(); GAPA(C1=__builtin_amdgcn_mfma_f32_32x32x16_bf16(kf[3],qr[1],C1,0,0,0),   P0[14],P0[15],P1[0],P1[1],   pw1[2]=PKW(P0,12),pw1[3]=PKW(P0,14), pw1); \
    VRD(2); SBAR(); GAPA(C0=__builtin_amdgcn_mfma_f32_32x32x16_bf16(kf[4],qr[2],C0,0,0,0),   P1[2],P1[3],P1[4],P1[5],     pw2[0]=PKW(P1,0), pw2[1]=PKW(P1,2), pw2); \
    VRD(6); SBAR(); GAPA(C1=__builtin_amdgcn_mfma_f32_32x32x16_bf16(kf[5],qr[2],C1,0,0,0),   P1[6],P1[7],P1[8],P1[9],     pw2[2]=PKW(P1,4), pw2[3]=PKW(P1,6), pw2); \
    VRD(3); SBAR(); GAPA(C0=__builtin_amdgcn_mfma_f32_32x32x16_bf16(kf[6],qr[3],C0,0,0,0),   P1[10],P1[11],P1[12],P1[13], pw3[0]=PKW(P1,8), pw3[1]=PKW(P1,10), pw3); \
    VRD(7); SBAR(); GAPA(C1=__builtin_amdgcn_mfma_f32_32x32x16_bf16(kf[7],qr[3],C1,0,0,0),   P1[14],P1[15],0.f,0.f,       pw3[2]=PKW(P1,12),pw3[3]=PKW(P1,14), pw3); \
    l_reg+=sacc; \
    if(GK){DMA_K((t)+3,sl_cur);} if(GV){DMA_V((t)+1,sl_next);} \
    CMASK(C0,C1,t); \
    { float a=MX3(C0[0],C0[1],C1[0]),b=MX3(C0[2],C0[3],C1[1]); a=MX3(a,C1[2],C1[3]); \
      _Pragma("unroll") for(int r=4;r<16;r+=4){a=MX3(a,C0[r],C0[r+1]);b=MX3(b,C0[r+2],C0[r+3]);a=MX3(a,C1[r],C1[r+1]);b=MX3(b,C1[r+2],C1[r+3]);} \
      float rm=__builtin_fmaxf(a,b); { auto rr=__builtin_amdgcn_permlane32_swap(__float_as_uint(rm),__float_as_uint(rm),false,false); rm=__builtin_fmaxf(__uint_as_float(rr[0]),__uint_as_float(rr[1])); } \
      resc=false; \
      if(__builtin_expect(__any(rm>(float)THRL),0)){ const float dl=__builtin_fmaxf(rm,0.f); mhat+=dl; \
        _Pragma("unroll") for(int r=0;r<16;++r){C0[r]-=dl;C1[r]-=dl;} \
        _Pragma("unroll") for(int r=0;r<16;++r)negm[r]=-mhat; asm volatile("":"+v"(negm)); \
        const float f=__builtin_amdgcn_exp2f(-dl); l_reg*=f; if(hi==0)wsf[r32]=f; resc=true; } } \
    SBAR(); \
    GAPB(o[0]=__builtin_amdgcn_mfma_f32_32x32x16_bf16(PAF(0),VFR(0),o[0],0,0,0), C0,0); \
    GAPB(o[1]=__builtin_amdgcn_mfma_f32_32x32x16_bf16(PAF(0),VFR(4),o[1],0,0,0), C0,4); \
    KRD(GL,0); GAPB(o[0]=__builtin_amdgcn_mfma_f32_32x32x16_bf16(PAF(1),VFR(1),o[0],0,0,0), C0,8); \
    KRD(GL,1); GAPB(o[1]=__builtin_amdgcn_mfma_f32_32x32x16_bf16(PAF(1),VFR(5),o[1],0,0,0), C0,12); \
    KRD(GL,2); GAPB(o[0]=__builtin_amdgcn_mfma_f32_32x32x16_bf16(PAF(2),VFR(2),o[0],0,0,0), C1,0); \
    KRD(GL,3); GAPB(o[1]=__builtin_amdgcn_mfma_f32_32x32x16_bf16(PAF(2),VFR(6),o[1],0,0,0), C1,4); \
    GAPB(o[0]=__builtin_amdgcn_mfma_f32_32x32x16_bf16(PAF(3),VFR(3),o[0],0,0,0), C1,8); \
    GAPB(o[1]=__builtin_amdgcn_mfma_f32_32x32x16_bf16(PAF(3),VFR(7),o[1],0,0,0), C1,12); \
    }while(0)
  int t=1;
  #undef CMASK
  #define CMASK(P0,P1,t) do{}while(0)
  for(;t+5<NT;t+=2){
    STEP(pB0,pB1,pA0,pA1,t,true,true,true);     WAIT_BAR(2); RESC(); ROT();
    STEP(pA0,pA1,pB0,pB1,t+1,true,true,true);   WAIT_BAR(2); RESC(); ROT();
  }
  #undef CMASK
  #define CMASK(P0,P1,t) do{}while(0)
  #define ENDW(tt) do{ if((tt)+3<NT){WAIT_BAR(2);} else if((tt)+2<NT){WAIT_BAR(1);} else {WAIT_BAR(0);} }while(0)
  for(;t+1<NT;t+=2){
    STEP(pB0,pB1,pA0,pA1,t,(t+3<NT),(t+1<NT),(t+1<NT));       ENDW(t);   RESC(); ROT();
    STEP(pA0,pA1,pB0,pB1,t+1,(t+4<NT),(t+2<NT),(t+2<NT));     ENDW(t+1); RESC(); ROT();
  }
  STEP(pB0,pB1,pA0,pA1,NT-1,false,false,false); RESC();
  { float sacc=pB0[0]+pB0[1]; _Pragma("unroll") for(int r=2;r<16;++r)sacc+=pB0[r]; _Pragma("unroll") for(int r=0;r<16;++r)sacc+=pB1[r]; l_reg+=sacc;
    pw0=(u32x4){PKW(pB0,0),PKW(pB0,2),PKW(pB0,4),PKW(pB0,6)};pw1=(u32x4){PKW(pB0,8),PKW(pB0,10),PKW(pB0,12),PKW(pB0,14)};pw2=(u32x4){PKW(pB1,0),PKW(pB1,2),PKW(pB1,4),PKW(pB1,6)};pw3=(u32x4){PKW(pB1,8),PKW(pB1,10),PKW(pB1,12),PKW(pB1,14)};
    SBAR(); pv(o,vb0+sl_cur,PAF(0),PAF(1),PAF(2),PAF(3)); }
  #undef PKW
  #undef PAF
  #undef VFR
  #undef PIN
  #undef MX3
  #undef GAPA
  #undef GAPB
  #undef EX
  #undef VRD
  #undef KRD
  #undef STEP
  #undef ENDW
  {auto rr=__builtin_amdgcn_permlane32_swap(__float_as_uint(l_reg),__float_as_uint(l_reg),false,false);l_reg=__uint_as_float(rr[0])+__uint_as_float(rr[1]);}
  if(hi==0)wsf[32+r32]=l_reg;asm volatile("s_waitcnt lgkmcnt(0)":::"memory");
  float rli[16];
  #pragma unroll
  for(int r=0;r<16;++r)rli[r]=__builtin_amdgcn_rcpf(wsf[32+crow(r,hi)]);
  bf16*Ow=O+(rowbase+q0+wid*QBLK)*PQ+h*D;
  { bf16*stg=(bf16*)(shm+LDS_OST)+wid*2048;
    #pragma unroll
    for(int r=0;r<16;++r){const int orow=crow(r,hi);
      #pragma unroll
      for(int d0=0;d0<2;++d0)stg[orow*64+d0*32+r32]=__float2bfloat16(o[d0][r]*rli[r]);}
    asm volatile("s_waitcnt lgkmcnt(0)":::"memory");
    #pragma unroll
    for(int i=0;i<4;++i){const int row=i*8+(lane>>3),ch=lane&7; const u32x4 v=*(const u32x4*)(stg+row*64+ch*8); ATTN_STORE16(Ow+(long)row*PQ+ch*8,v);} }
  asm volatile("s_waitcnt lgkmcnt(0)\n\ts_barrier":::"memory");
  #undef DMA_K
  #undef DMA_V
  #undef CMASK
  #undef START
  #undef RESC
  #undef ROT
}
constexpr int ATTN_LDS_BYTES=LDS_BYTES;
#undef SBAR
#undef WAIT_BAR
}
#define LAS __attribute__((address_space(3)))
constexpr int SEQ = 8192, BATCH = 4, MTOK = BATCH * SEQ, DMODEL = 1024, DEPTH = 4, DFF = 2816, INW = 6656, GATEW = 3072;
constexpr float RMS_EPS = 1e-6f;
constexpr float QSCALE = 0.125f * 1.4426950408889634f;
constexpr int NWAVES = 8;
typedef pg8::bf16_t bf16_t;
typedef pg8::f32x4 f32x4;
typedef pg8::bf16x8 bf16x8;
typedef unsigned u32x2 __attribute__((ext_vector_type(2)));
typedef unsigned u32x4v __attribute__((ext_vector_type(4)));

constexpr size_t W_IN = 0, W_A = W_IN + (size_t)INW * 1024, W_B = W_A + 1024 * 512, W_C = W_B + 1024 * 256, W_O3 = W_C + 1024 * 512,
                 W_GU = W_O3 + (size_t)1024 * 3072, W_D = W_GU + (size_t)2 * DFF * 1024, W_LAYER = W_D + (size_t)1024 * DFF;
static_assert(W_LAYER * 2 == 38u * 1048576u, "weight block is 38 MiB");
constexpr size_t MiB = 1u << 20;
constexpr size_t WS_W = 1 * MiB, WS_H = 153 * MiB, WS_QA = 217 * MiB, WS_OB = 249 * MiB, WS_PC = 265 * MiB, WS_BIG = 297 * MiB, WS_PSS1 = 489 * MiB, WS_PSS2 = 491 * MiB, WS_END = 493 * MiB;
constexpr size_t BIG_KA = 0, BIG_VA = 8 * MiB, BIG_QB = 16 * MiB, BIG_KB = 64 * MiB, BIG_VB = 112 * MiB, BIG_UC = 160 * MiB;
constexpr int LDS_BYTES = 147456;

__device__ __forceinline__ float bf2f(unsigned short h) { return __builtin_bit_cast(float, (unsigned)h << 16); }
__device__ __forceinline__ float bflo(unsigned w) { return __builtin_bit_cast(float, w << 16); }
__device__ __forceinline__ float bfhi(unsigned w) { return __builtin_bit_cast(float, w & 0xffff0000u); }
__device__ __forceinline__ unsigned pkbf(float lo, float hi) { return pg8::cvt_pk_bf16(lo, hi); }
__device__ __forceinline__ int finv(int f) { return (f & ~255) | (((f >> 5) & 1) << 7) | (((f >> 6) & 3) << 5) | (f & 31); }
__device__ __forceinline__ void sincos_rad(float ang, float& s, float& c) { float r = __builtin_amdgcn_fractf(ang * 0.15915494309189535f); s = __builtin_amdgcn_sinf(r); c = __builtin_amdgcn_cosf(r); }
__device__ __forceinline__ float sigmoidf_(float v) { return __builtin_amdgcn_rcpf(1.0f + __builtin_amdgcn_exp2f(-1.4426950408889634f * v)); }

__device__ __forceinline__ float row_rs(const float* PSS, int row) { const pg8::f32x4* p = (const pg8::f32x4*)(PSS + (size_t)row * 16); const pg8::f32x4 s = (p[0] + p[1]) + (p[2] + p[3]);
    return __builtin_amdgcn_rsqf(((s[0] + s[1]) + (s[2] + s[3])) * (1.f / DMODEL) + RMS_EPS); }
__device__ __forceinline__ void rows_rs(const float* PSS, int rowbase, int lane, float (&rsx)[8]) {
    const int r16 = lane >> 2, q = lane & 3, fr = lane & 15; float part[8];
#pragma unroll
    for (int i = 0; i < 8; ++i) { const pg8::f32x4 v = *(const pg8::f32x4*)(PSS + (size_t)(rowbase + 128 * (i >> 2) + 16 * (i & 3) + r16) * 16 + 4 * q); part[i] = (v[0] + v[1]) + (v[2] + v[3]); }
#pragma unroll
    for (int i = 0; i < 8; ++i) { float t = part[i]; t += __shfl_xor(t, 1); t += __shfl_xor(t, 2); const float rs = __builtin_amdgcn_rsqf(t * (1.f / DMODEL) + RMS_EPS); rsx[i] = __shfl(rs, 4 * fr); }
}
namespace pg8 {
struct EpiInProj1 {
    static constexpr bool PERM = false, AFTER_DRAIN = false;
    bf16_t *QA, *KA, *VA, *QB, *KB, *VB, *UC; const float *qn_a, *kn_a, *qn_b, *kn_b; const float* PSS;
    __device__ __forceinline__ void operator()(const f32x4 (&acc)[2][2][4][2], const Unit& u, int wr, int wc, int fr, int fq) const {
        const int f0 = u.pn * BM + wc * 64;
        bf16_t* dst; int ld, mode; const float* gain = nullptr; float osc = 1.f;
        if (f0 < 512) { dst = QA + f0; ld = 512; mode = 1; gain = qn_a; osc = QSCALE; }
        else if (f0 < 640) { dst = KA + (f0 - 512); ld = 128; mode = 1; gain = kn_a; }
        else if (f0 < 768) { dst = VA + (f0 - 640); ld = 128; mode = 0; }
        else if (f0 < 1536) { dst = QB + (f0 - 768); ld = 768; mode = 2; gain = qn_b; osc = QSCALE; }
        else if (f0 < 2304) { dst = KB + (f0 - 1536); ld = 768; mode = 2; gain = kn_b; }
        else if (f0 < 3072) { dst = VB + (f0 - 2304); ld = 768; mode = 0; }
        else { dst = UC + (f0 - 3072); ld = 512; mode = 0; }
        const int row0 = u.pm * BM + wr * 64 + fr;
        float rs8[8]; rows_rs(PSS, u.pm * BM + wr * 64, fr + 16 * fq, rs8);
        if (mode == 0) {
#pragma unroll
            for (int ai = 0; ai < 2; ++ai)
#pragma unroll
                for (int m = 0; m < 4; ++m) { bf16_t* rp = dst + (size_t)(row0 + ai * HALF + m * 16) * ld + 4 * fq; const float rsx = rs8[4 * ai + m];
#pragma unroll
                    for (int bj = 0; bj < 2; ++bj)
#pragma unroll
                        for (int n = 0; n < 2; ++n) { const f32x4 v = acc[ai][bj][m][n] * rsx; u32x2 w; w.x = cvt_pk_bf16(v[0], v[1]); w.y = cvt_pk_bf16(v[2], v[3]); *(u32x2*)(rp + 32 * bj + 16 * n) = w; } }
            return;
        }
        float inv[2][4];
        const float L2T = 13.287712379549449f;
#pragma unroll
        for (int n = 0; n < 2; ++n)
#pragma unroll
            for (int j = 0; j < 4; ++j) inv[n][j] = (mode == 2) ? __builtin_amdgcn_exp2f(-(float)(16 * n + 4 * fq + j) * (L2T / 32.f)) : __builtin_amdgcn_exp2f(-(float)(4 * fq + j) * (L2T / 16.f));
#pragma unroll
        for (int ai = 0; ai < 2; ++ai)
#pragma unroll
            for (int m = 0; m < 4; ++m) {
                const int row = row0 + ai * HALF + m * 16; const int t = row & (SEQ - 1); const float rsx = rs8[4 * ai + m];
                float ss = 0.f;
#pragma unroll
                for (int bj = 0; bj < 2; ++bj)
#pragma unroll
                    for (int n = 0; n < 2; ++n) { const f32x4 v = acc[ai][bj][m][n] * rsx; ss += (v[0] * v[0] + v[1] * v[1]) + (v[2] * v[2] + v[3] * v[3]); }
                ss += __shfl_xor(ss, 16); ss += __shfl_xor(ss, 32);
                const float rs = __builtin_amdgcn_rsqf(ss * (1.f / 64.f) + RMS_EPS);
                f32x4 y[2][2], o[2][2];
#pragma unroll
                for (int bj = 0; bj < 2; ++bj)
#pragma unroll
                    for (int n = 0; n < 2; ++n) y[bj][n] = acc[ai][bj][m][n] * (rs * rsx) * *(const f32x4*)(gain + 32 * bj + 16 * n + 4 * fq);
                if (mode == 2) {
                    const float tf = (float)t;
#pragma unroll
                    for (int n = 0; n < 2; ++n)
#pragma unroll
                        for (int j = 0; j < 4; ++j) { float s, c; sincos_rad(tf * inv[n][j], s, c); const float x1 = y[0][n][j], x2 = y[1][n][j]; o[0][n][j] = x1 * c - x2 * s; o[1][n][j] = x2 * c + x1 * s; }
                } else {
#pragma unroll
                    for (int bj = 0; bj < 2; ++bj) { const float pf = (float)(bj == 0 ? (t >> 6) : (t & 63));
#pragma unroll
                        for (int j = 0; j < 4; ++j) { float s, c; sincos_rad(pf * inv[0][j], s, c); const float x1 = y[bj][0][j], x2 = y[bj][1][j]; o[bj][0][j] = x1 * c - x2 * s; o[bj][1][j] = x2 * c + x1 * s; } }
                }
                bf16_t* rp = dst + (size_t)row * ld + 4 * fq;
#pragma unroll
                for (int bj = 0; bj < 2; ++bj)
#pragma unroll
                    for (int n = 0; n < 2; ++n) { const f32x4 v = o[bj][n] * osc; u32x2 w; w.x = cvt_pk_bf16(v[0], v[1]); w.y = cvt_pk_bf16(v[2], v[3]); *(u32x2*)(rp + 32 * bj + 16 * n) = w; }
            }
    }
};
struct EpiGates {
    static constexpr bool PERM = false, AFTER_DRAIN = false;
    bf16_t* G; const float* bias; const float* PSS;
    __device__ __forceinline__ void operator()(const f32x4 (&acc)[2][2][4][2], const Unit& u, int wr, int wc, int fr, int fq) const {
        const int row0 = u.pm * BM + wr * 64 + fr, col0 = u.pn * BM + wc * 64 + 4 * fq;
        float rs8[8]; rows_rs(PSS, u.pm * BM + wr * 64, fr + 16 * fq, rs8);
#pragma unroll
        for (int bj = 0; bj < 2; ++bj)
#pragma unroll
            for (int n = 0; n < 2; ++n) { const int col = col0 + 32 * bj + 16 * n; const f32x4 b = *(const f32x4*)(bias + col);
#pragma unroll
                for (int ai = 0; ai < 2; ++ai)
#pragma unroll
                    for (int m = 0; m < 4; ++m) { const f32x4 v = acc[ai][bj][m][n] * rs8[4 * ai + m] + b; u32x2 w; w.x = cvt_pk_bf16(sigmoidf_(v[0]), sigmoidf_(v[1])); w.y = cvt_pk_bf16(sigmoidf_(v[2]), sigmoidf_(v[3]));
                        *(u32x2*)(G + (size_t)(row0 + ai * HALF + m * 16) * GATEW + col) = w; } }
    }
};
struct EpiMerge {
    static constexpr bool PERM = false, AFTER_DRAIN = false;
    const bf16_t* G; bf16_t* Mo; int coloff; int first;
    __device__ __forceinline__ void operator()(const f32x4 (&acc)[2][2][4][2], const Unit& u, int wr, int wc, int fr, int fq) const {
        const int row0 = u.pm * BM + wr * 64 + fr, col0 = u.pn * BM + wc * 64 + 4 * fq;
#pragma unroll
        for (int ai = 0; ai < 2; ++ai)
#pragma unroll
            for (int m = 0; m < 4; ++m) { const int row = row0 + ai * HALF + m * 16; const bf16_t* gp = G + (size_t)row * GATEW + coloff + col0; bf16_t* mp = Mo + (size_t)row * DMODEL + col0;
                u32x2 gv[2][2], mv[2][2];
#pragma unroll
                for (int bj = 0; bj < 2; ++bj)
#pragma unroll
                    for (int n = 0; n < 2; ++n) { gv[bj][n] = *(const u32x2*)(gp + 32 * bj + 16 * n); mv[bj][n] = first ? (u32x2){0u, 0u} : *(const u32x2*)(mp + 32 * bj + 16 * n); }
#pragma unroll
                for (int bj = 0; bj < 2; ++bj)
#pragma unroll
                    for (int n = 0; n < 2; ++n) { const f32x4 v = acc[ai][bj][m][n]; const u32x2 gg = gv[bj][n], mm = mv[bj][n]; u32x2 w;
                        w.x = cvt_pk_bf16(bflo(mm.x) + bflo(gg.x) * v[0], bfhi(mm.x) + bfhi(gg.x) * v[1]); w.y = cvt_pk_bf16(bflo(mm.y) + bflo(gg.y) * v[2], bfhi(mm.y) + bfhi(gg.y) * v[3]); *(u32x2*)(mp + 32 * bj + 16 * n) = w; } }
    }
};
struct EpiRes {
    static constexpr bool PERM = false, AFTER_DRAIN = false;
    const float* base; float* out; bf16_t* XB; float* PSS;
    __device__ __forceinline__ void operator()(const f32x4 (&acc)[2][2][4][2], const Unit& u, int wr, int wc, int fr, int fq) const {
        const int row0 = u.pm * BM + wr * 64 + fr, col0 = u.pn * BM + wc * 64 + 4 * fq;
#pragma unroll
        for (int ai = 0; ai < 2; ++ai)
#pragma unroll
            for (int m = 0; m < 4; ++m) { const int row = row0 + ai * HALF + m * 16; const size_t off = (size_t)row * DMODEL + col0;
                f32x4 bv[2][2];
#pragma unroll
                for (int bj = 0; bj < 2; ++bj)
#pragma unroll
                    for (int n = 0; n < 2; ++n) bv[bj][n] = *(const f32x4*)(base + off + 32 * bj + 16 * n);
                float ss = 0.f;
#pragma unroll
                for (int bj = 0; bj < 2; ++bj)
#pragma unroll
                    for (int n = 0; n < 2; ++n) { const f32x4 x = bv[bj][n] + acc[ai][bj][m][n]; *(f32x4*)(out + off + 32 * bj + 16 * n) = x; ss += (x[0] * x[0] + x[1] * x[1]) + (x[2] * x[2] + x[3] * x[3]);
                        u32x2 w; w.x = cvt_pk_bf16(x[0], x[1]); w.y = cvt_pk_bf16(x[2], x[3]); *(u32x2*)(XB + off + 32 * bj + 16 * n) = w; }
                ss += __shfl_xor(ss, 16); ss += __shfl_xor(ss, 32);
                if (fq == 0) PSS[(size_t)row * 16 + u.pn * 4 + wc] = ss; }
    }
};
struct EpiFfn1 {
    static constexpr bool PERM = false, AFTER_DRAIN = false;
    bf16_t* ACT; const float* PSS;
    __device__ __forceinline__ void operator()(const f32x4 (&acc)[2][2][4][2], const Unit& u, int wr, int wc, int fr, int fq) const {
        const int row0 = u.pm * BM + wr * 64 + fr, col0 = u.pn * HALF + wc * 32 + 4 * fq;
        float rs8[8]; rows_rs(PSS, u.pm * BM + wr * 64, fr + 16 * fq, rs8);
#pragma unroll
        for (int ai = 0; ai < 2; ++ai)
#pragma unroll
            for (int m = 0; m < 4; ++m) { bf16_t* rp = ACT + (size_t)(row0 + ai * HALF + m * 16) * DFF + col0; const float rsx = rs8[4 * ai + m];
#pragma unroll
                for (int n = 0; n < 2; ++n) { const f32x4 gt = acc[ai][0][m][n] * rsx, up = acc[ai][1][m][n] * rsx; f32x4 r;
#pragma unroll
                    for (int j = 0; j < 4; ++j) r[j] = gt[j] * sigmoidf_(gt[j]) * up[j];
                    u32x2 w; w.x = cvt_pk_bf16(r[0], r[1]); w.y = cvt_pk_bf16(r[2], r[3]); *(u32x2*)(rp + 16 * n) = w; } }
    }
};
}

namespace attnb {
typedef short s16x4 __attribute__((ext_vector_type(4)));
typedef short v4i16_t __attribute__((ext_vector_type(4)));
constexpr int PB = 768, VROW = 144, WAVE_LDS = 32 * VROW;
__device__ __forceinline__ s16x4 vtr(LAS const char* p) { return __builtin_bit_cast(s16x4, __builtin_amdgcn_ds_read_tr16_b64_v4i16((LAS v4i16_t*)p)); }

template <int DIL>
__device__ __forceinline__ void group(const bf16_t* __restrict__ Qg, const bf16_t* __restrict__ Kg, const bf16_t* __restrict__ Vg, int t0r, LAS char* vl, int lane, float& m_run, float& l_run, f32x4 (&o)[4]) {
    constexpr int STEP = 16 / DIL, NK = 15 * STEP + 129, NC = (NK + 31) / 32, LD = SEQ / DIL;
    const int fr = lane & 15, fq = lane >> 4;
    const int rr = t0r & (DIL - 1), lk0 = t0r / DIL - 64;
    bf16x8 qf[2];
    { const bf16_t* qp = Qg + (size_t)(t0r + 16 * fr) * PB + 8 * fq; qf[0] = *(const bf16x8*)qp; qf[1] = *(const bf16x8*)(qp + 32); }
    bf16x8 kf[2][2][2], vr[2][4];
#define AB_LOAD(c, B) do { \
        _Pragma("unroll") for (int T = 0; T < 2; ++T) { int lk = lk0 + 32 * (c) + 16 * T + fr; lk = lk < 0 ? 0 : (lk > LD - 1 ? LD - 1 : lk); \
            const bf16_t* kp = Kg + (size_t)(lk * DIL + rr) * PB + 8 * fq; kf[B][T][0] = *(const bf16x8*)kp; kf[B][T][1] = *(const bf16x8*)(kp + 32); } \
        _Pragma("unroll") for (int i = 0; i < 4; ++i) { int lk = lk0 + 32 * (c) + (lane >> 3) + 8 * i; lk = lk < 0 ? 0 : (lk > LD - 1 ? LD - 1 : lk); \
            vr[B][i] = *(const bf16x8*)(Vg + (size_t)(lk * DIL + rr) * PB + 8 * (lane & 7)); } } while (0)
    AB_LOAD(0, 0);
    LAS char* vw = vl + (lane >> 3) * VROW + (lane & 7) * 16;
    LAS const char* vrd = vl + (4 * fq + (fr >> 2)) * VROW + (fr & 3) * 8;
#define AB_COMPUTE(c, B) do { \
_Pragma("unroll") \
        for (int i = 0; i < 4; ++i) *(LAS bf16x8*)(vw + 8 * i * VROW) = vr[B][i]; \
        f32x4 s[2]; \
_Pragma("unroll") \
        for (int T = 0; T < 2; ++T) { s[T] = __builtin_amdgcn_mfma_f32_16x16x32_bf16(kf[B][T][0], qf[0], (f32x4){0.f, 0.f, 0.f, 0.f}, 0, 0, 0); s[T] = __builtin_amdgcn_mfma_f32_16x16x32_bf16(kf[B][T][1], qf[1], s[T], 0, 0, 0); } \
        bool ok[2][4]; float mx = -1e30f; \
_Pragma("unroll") \
        for (int T = 0; T < 2; ++T) \
_Pragma("unroll") \
            for (int r = 0; r < 4; ++r) { const int k = 32 * (c) + 16 * T + 4 * fq + r, lk = lk0 + k; ok[T][r] = (lk >= 0) && (lk < LD) && (k >= STEP * fr) && (k <= STEP * fr + 128); \
                mx = fmaxf(mx, ok[T][r] ? s[T][r] : -1e30f); } \
        mx = fmaxf(mx, __shfl_xor(mx, 16)); mx = fmaxf(mx, __shfl_xor(mx, 32)); \
        const float m_new = fmaxf(m_run, mx), alpha = __builtin_amdgcn_exp2f(m_run - m_new); \
        float p[2][4], ps = 0.f; \
_Pragma("unroll") \
        for (int T = 0; T < 2; ++T) \
_Pragma("unroll") \
            for (int r = 0; r < 4; ++r) { p[T][r] = ok[T][r] ? __builtin_amdgcn_exp2f(s[T][r] - m_new) : 0.f; ps += p[T][r]; } \
        l_run = l_run * alpha + ps; m_run = m_new; \
_Pragma("unroll") \
        for (int dt = 0; dt < 4; ++dt) o[dt] = o[dt] * alpha; \
        u32x4v pw; pw.x = pkbf(p[0][0], p[0][1]); pw.y = pkbf(p[0][2], p[0][3]); pw.z = pkbf(p[1][0], p[1][1]); pw.w = pkbf(p[1][2], p[1][3]); \
        const bf16x8 pf = __builtin_bit_cast(bf16x8, pw); \
_Pragma("unroll") \
        for (int dt = 0; dt < 4; ++dt) { const s16x4 v0 = vtr(vrd + dt * 32), v1 = vtr(vrd + 16 * VROW + dt * 32); \
            const bf16x8 vf = (bf16x8){v0[0], v0[1], v0[2], v0[3], v1[0], v1[1], v1[2], v1[3]}; \
            o[dt] = __builtin_amdgcn_mfma_f32_16x16x32_bf16(vf, pf, o[dt], 0, 0, 0); } \
    } while (0)
#pragma unroll 1
    for (int c = 0; c < NC; c += 2) {
        if (c + 1 < NC) AB_LOAD(c + 1, 1);
        AB_COMPUTE(c, 0);
        if (c + 2 < NC) AB_LOAD(c + 2, 0);
        if (c + 1 < NC) AB_COMPUTE(c + 1, 1);
    }
#undef AB_COMPUTE
#undef AB_LOAD
}
__device__ __forceinline__ void unit(int b, int slot, int q0, const bf16_t* QB, const bf16_t* KB, const bf16_t* VB, bf16_t* OB, LAS char* lds, int wid, int lane) {
    LAS char* vl = lds + wid * WAVE_LDS;
    const size_t seq0 = (size_t)b * SEQ * PB;
    const int fr = lane & 15, fq = lane >> 4;
    for (int rs = 0; rs < 2; ++rs) {
        const int t0r = q0 + wid + 8 * rs;
        float m_run = -1e30f, l_run = 0.f; f32x4 o[4];
#pragma unroll
        for (int dt = 0; dt < 4; ++dt) o[dt] = (f32x4){0.f, 0.f, 0.f, 0.f};
        group<1>(QB + seq0 + 0 * 256 + slot * 64, KB + seq0 + 0 * 256 + slot * 64, VB + seq0 + 0 * 256 + slot * 64, t0r, vl, lane, m_run, l_run, o);
        group<4>(QB + seq0 + 1 * 256 + slot * 64, KB + seq0 + 1 * 256 + slot * 64, VB + seq0 + 1 * 256 + slot * 64, t0r, vl, lane, m_run, l_run, o);
        group<16>(QB + seq0 + 2 * 256 + slot * 64, KB + seq0 + 2 * 256 + slot * 64, VB + seq0 + 2 * 256 + slot * 64, t0r, vl, lane, m_run, l_run, o);
        float l = l_run; l += __shfl_xor(l, 16); l += __shfl_xor(l, 32);
        const float il = __builtin_amdgcn_rcpf(l);
        bf16_t* op = OB + ((size_t)b * SEQ + t0r + 16 * fr) * 256 + slot * 64 + 4 * fq;
#pragma unroll
        for (int dt = 0; dt < 4; ++dt) { const f32x4 v = o[dt] * il; u32x2 w; w.x = pkbf(v[0], v[1]); w.y = pkbf(v[2], v[3]); *(u32x2*)(op + 16 * dt) = w; }
    }
}
}

#define RLX_AGENT __ATOMIC_RELAXED, __HIP_MEMORY_SCOPE_AGENT
#define XB_TMO      128
#define XB_XCNT(j)  (256  + 64 * (j))
#define XB_XSUB(j)  (1280 + 64 * (j))
#define XB_XGEN(j)  (2304 + 64 * (j))
#define XB_TOP      3328
#define XB_TOPGEN   3392
#define XCD_BAR_WORDS 3456
#define XB_SPIN_CAP (1u << 18)

__device__ __forceinline__ unsigned xb_ld(unsigned* p)              { return __hip_atomic_load(p, __ATOMIC_RELAXED, __HIP_MEMORY_SCOPE_AGENT); }
__device__ __forceinline__ unsigned xb_add(unsigned* p, unsigned v) { return __hip_atomic_fetch_add(p, v, __ATOMIC_RELAXED, __HIP_MEMORY_SCOPE_AGENT); }
__device__ __forceinline__ unsigned xb_xcc_id() { return (unsigned)__builtin_amdgcn_s_getreg((3 << 11) | 20) & 0xFu; }
#define XB_SPIN(cond, bar) do { unsigned _sp = 0; while (cond) { __builtin_amdgcn_s_sleep(1); \
    if ((++_sp & 255u) == 0u) { if (xb_ld(&(bar)[XB_TMO])) break; if (_sp > XB_SPIN_CAP) { atomicAdd(&(bar)[XB_TMO], 1u); break; } } } } while (0)

struct XcdBarrier {
    unsigned* bar; unsigned x;
    volatile LAS unsigned* st;
};

__device__ __forceinline__ XcdBarrier xcd_barrier_post(unsigned* bar, volatile LAS unsigned* st) {
    XcdBarrier b; b.bar = bar; b.x = xb_xcc_id(); b.st = st;
    if (threadIdx.x == 0) (void)xb_add(&bar[XB_XCNT(b.x)], 1u);
    return b;
}
__device__ __forceinline__ void xcd_barrier_complete(unsigned* bar, unsigned x, unsigned& nloc, unsigned& nx) {
    const unsigned G = gridDim.x * gridDim.y * gridDim.z;
    unsigned sum, cnt, mine, sp = 0u;
    for (;;) {
        sum = 0u; cnt = 0u; mine = 0u;
#pragma unroll
        for (unsigned j = 0; j < 16; ++j) { const unsigned c = xb_ld(&bar[XB_XCNT(j)]); sum += c; cnt += (c > 0u) ? 1u : 0u; mine = (j == x) ? c : mine; }
        if (sum == G) break;
        __builtin_amdgcn_s_sleep(1);
        if ((++sp & 255u) == 0u) { if (xb_ld(&bar[XB_TMO])) break; if (sp > XB_SPIN_CAP) { atomicAdd(&bar[XB_TMO], 1u); break; } }
    }
    nloc = mine > 0u ? mine : 1u; nx = cnt > 0u ? cnt : 1u;
}

__device__ __forceinline__ void xcd_barrier(const XcdBarrier& b) {
    asm volatile("s_waitcnt vmcnt(0)" ::: "memory");
    __syncthreads();
    if (threadIdx.x == 0) {
        unsigned* bar = b.bar;
        __builtin_amdgcn_s_waitcnt(0);
        unsigned nloc = b.st[0], nx = b.st[1];
        if (nloc == 0u) { xcd_barrier_complete(bar, b.x, nloc, nx); b.st[0] = nloc; b.st[1] = nx; }
        const unsigned old = xb_add(&bar[XB_XSUB(b.x)], 1u);
        const unsigned gen = old / nloc;
        if (old + 1u == (gen + 1u) * nloc) {
            __builtin_amdgcn_fence(__ATOMIC_RELEASE, "agent");
            asm volatile("s_waitcnt vmcnt(0)" ::: "memory");
            const unsigned og = xb_add(&bar[XB_TOP], 1u);
            const unsigned tg = og / nx;
            if (og + 1u == (tg + 1u) * nx) xb_add(&bar[XB_TOPGEN], 1u);
            else XB_SPIN(xb_ld(&bar[XB_TOPGEN]) == tg, bar);
            __builtin_amdgcn_fence(__ATOMIC_ACQUIRE, "agent");
            xb_add(&bar[XB_XGEN(b.x)], 1u);
            asm volatile("s_waitcnt vmcnt(0)" ::: "memory");
        } else {
            XB_SPIN(xb_ld(&bar[XB_XGEN(b.x)]) == gen, bar);
            __builtin_amdgcn_fence(__ATOMIC_ACQUIRE, "agent");
            asm volatile("s_waitcnt vmcnt(0)" ::: "memory");
        }
    }
    __syncthreads();
}

struct Args { const float* in[18]; float* out; unsigned char* ws; int ph_lo, ph_hi; };
constexpr int NPHASE = 1 + 7 * DEPTH;

__device__ __forceinline__ float wave_sum(float v) {
#pragma unroll
    for (int o = 1; o < 64; o <<= 1) v += __shfl_xor(v, o);
    return v;
}
__device__ __forceinline__ void tr_item(const float* __restrict__ W, int ldn, int k0, int n0, bf16_t* __restrict__ dst, int dld, int prow0, int dk0, int ncopy, int dkstride, LAS float* scr, int lane, const float* __restrict__ kg = nullptr) {
#pragma unroll 8
    for (int i = 0; i < 32; ++i) { const int kk = 2 * i + (lane >> 5); float w = W[(size_t)(k0 + kk) * ldn + n0 + (lane & 31)]; if (kg) w *= kg[k0 + kk]; scr[kk * 33 + (lane & 31)] = w; }
    asm volatile("s_waitcnt lgkmcnt(0)" ::: "memory");
    const int c = lane & 7;
#pragma unroll
    for (int j = 0; j < 4; ++j) { const int n = (lane >> 3) + 8 * j; const LAS float* s = scr + (8 * c) * 33 + n;
        u32x4v o; o.x = pkbf(s[0 * 33], s[1 * 33]); o.y = pkbf(s[2 * 33], s[3 * 33]); o.z = pkbf(s[4 * 33], s[5 * 33]); o.w = pkbf(s[6 * 33], s[7 * 33]);
        for (int cp = 0; cp < ncopy; ++cp) *(u32x4v*)(dst + (size_t)(prow0 + n) * dld + dk0 + cp * dkstride + k0 + 8 * c) = o; }
    asm volatile("s_waitcnt lgkmcnt(0)" ::: "memory");
}

__global__ void __launch_bounds__(NWAVES * 64, 2) encoder_fwd(Args args) {
    extern __shared__ __attribute__((aligned(16))) unsigned char lds[];
    LAS unsigned char* L = (LAS unsigned char*)lds;
    const int G = gridDim.x, bx = blockIdx.x, vcu = (G % 8 == 0) ? (bx % 8) * (G / 8) + bx / 8 : bx;
    const int NGW = G * NWAVES;
    unsigned char* ws0 = args.ws;
    cg::grid_group grid = cg::this_grid();
    volatile LAS unsigned* bst = (volatile LAS unsigned*)(L + 131072 + 64);
    if (threadIdx.x < 2) bst[threadIdx.x] = 0u;
    __syncthreads();
    const XcdBarrier xbar = xcd_barrier_post((unsigned*)ws0, bst);

    for (int ph = args.ph_lo; ph < args.ph_hi; ++ph) {
        int tid_raw = threadIdx.x; asm volatile("" : "+v"(tid_raw));
        const int tid = tid_raw, lane = tid & 63, wid = __builtin_amdgcn_readfirstlane(tid >> 6), gw = vcu * NWAVES + wid; (void)tid;
            unsigned char* ws = ws0; asm volatile("" : "+s"(ws));
        bf16_t* Wall = (bf16_t*)(ws + WS_W);
        bf16_t* H = (bf16_t*)(ws + WS_H); bf16_t* QA = (bf16_t*)(ws + WS_QA); unsigned char* BIG = ws + WS_BIG;
        bf16_t* KA = (bf16_t*)(BIG + BIG_KA); bf16_t* VA = (bf16_t*)(BIG + BIG_VA); bf16_t* QB = (bf16_t*)(BIG + BIG_QB); bf16_t* KB = (bf16_t*)(BIG + BIG_KB);
        bf16_t* VB = (bf16_t*)(BIG + BIG_VB); bf16_t* UC = (bf16_t*)(BIG + BIG_UC); bf16_t* GT = (bf16_t*)BIG; bf16_t* ACT = (bf16_t*)BIG;
        bf16_t* OB = (bf16_t*)(ws + WS_OB); bf16_t* PC = (bf16_t*)(ws + WS_PC);
        bf16_t* XB1 = (bf16_t*)(ws + WS_QA); float* PSS1 = (float*)(ws + WS_PSS1); float* PSS2 = (float*)(ws + WS_PSS2);
        const float* xin = args.in[0]; float* xout = args.out;
        if (ph == 0) {
            LAS float* scr = (LAS float*)(L + wid * 16384);
            constexpr int I_IN = 16 * 208, I_A = 8 * 32, I_B = 4 * 32, I_O = 16 * 32, I_G = 16 * 88, I_D = 44 * 32, NIT = I_IN + I_A + I_B + I_O + 2 * I_G + I_D;
            for (int it = gw; it < DEPTH * NIT; it += NGW) {
                const int l = it / NIT; int r = it % NIT; bf16_t* Wl = Wall + (size_t)l * W_LAYER;
                if (r < I_IN) { const int kb = r / 208, nb = r % 208; tr_item(args.in[2] + (size_t)l * 1024 * INW, INW, 64 * kb, 32 * nb, Wl + W_IN, 1024, finv(32 * nb), 0, 1, 0, scr, lane, args.in[1] + l * DMODEL); continue; } r -= I_IN;
                if (r < I_A) { const int kb = r / 32, nb = r % 32; tr_item(args.in[10] + (size_t)l * 512 * 1024, 1024, 64 * kb, 32 * nb, Wl + W_A, 512, finv(32 * nb), 0, 1, 0, scr, lane); continue; } r -= I_A;
                if (r < I_B) { const int kb = r / 32, nb = r % 32; tr_item(args.in[11] + (size_t)l * 256 * 1024, 1024, 64 * kb, 32 * nb, Wl + W_B, 256, finv(32 * nb), 0, 1, 0, scr, lane); continue; } r -= I_B;
                if (r < I_O) { const int kb = r / 32, nb = r % 32; tr_item(args.in[13] + (size_t)l * 1024 * 1024, 1024, 64 * kb, 32 * nb, Wl + W_O3, 1024, finv(32 * nb), 0, 1, 0, scr, lane); continue; } r -= I_O;
                if (r < 2 * I_G) { const int up = r >= I_G; if (up) r -= I_G; const int kb = r / 88, nb = r % 88;
                    tr_item(args.in[up ? 16 : 15] + (size_t)l * 1024 * DFF, DFF, 64 * kb, 32 * nb, Wl + W_GU, 1024, finv(256 * (nb >> 2) + 64 * (nb & 3) + 32 * up), 0, 1, 0, scr, lane, args.in[14] + l * DMODEL); continue; } r -= 2 * I_G;
                { const int kb = r / 32, nb = r % 32; tr_item(args.in[17] + (size_t)l * DFF * 1024, 1024, 64 * kb, 32 * nb, Wl + W_D, DFF, finv(32 * nb), 0, 1, 0, scr, lane); }
            }
            for (int it = gw; it < DEPTH * 64 * 16; it += NGW) {
                const int l = it / 1024, c8 = (it >> 4) & 63, nb = it & 15, g = c8 >> 4, n = 64 * nb + lane;
                const float* lin = args.in[8] + ((size_t)l * 4 + g) * 128 * 128 + (size_t)((8 * c8) & 127) * 128;
                const float* sc = args.in[9] + l * 512 + 128 * g;
                const float* wc = args.in[12] + ((size_t)l * 512 + 128 * g) * 1024 + n;
                float a[8];
#pragma unroll
                for (int cc = 0; cc < 8; ++cc) a[cc] = 0.f;
                for (int d = 0; d < 128; ++d) { const float w = wc[(size_t)d * 1024] * sc[d];
#pragma unroll
                    for (int cc = 0; cc < 8; ++cc) a[cc] += lin[cc * 128 + d] * w; }
                u32x4v o; o.x = pkbf(a[0], a[1]); o.y = pkbf(a[2], a[3]); o.z = pkbf(a[4], a[5]); o.w = pkbf(a[6], a[7]);
                *(u32x4v*)(Wall + (size_t)l * W_LAYER + W_C + (size_t)finv(n) * 512 + 8 * c8) = o;
            }
            for (int m = gw; m < MTOK; m += NGW) {
                const f32x4* xr = (const f32x4*)(xin + (size_t)m * DMODEL) + lane; f32x4 v[4]; float sq = 0.f;
#pragma unroll
                for (int j = 0; j < 4; ++j) { v[j] = xr[64 * j]; sq += (v[j][0] * v[j][0] + v[j][1] * v[j][1]) + (v[j][2] * v[j][2] + v[j][3] * v[j][3]); }
                sq = wave_sum(sq);
                u32x2* o8 = (u32x2*)(H + (size_t)m * DMODEL) + lane;
#pragma unroll
                for (int j = 0; j < 4; ++j) { u32x2 w; w.x = pkbf(v[j][0], v[j][1]); w.y = pkbf(v[j][2], v[j][3]); o8[64 * j] = w; }
                if (lane < 16) PSS2[(size_t)m * 16 + lane] = (lane == 0) ? sq : 0.f;
            }
        } else {
            const int l = (ph - 1) / 7, sub = (ph - 1) % 7;
            const bf16_t* Wl = Wall + (size_t)l * W_LAYER;
            const float* xcur = (l == 0) ? xin : xout;
            if (sub == 0) {
#ifndef SKIP1
                pg8::Gemm g{H, Wl + W_IN, MTOK, 3584, 1024}; pg8::StaticOrder S; S.init(MTOK, 3584, G, bx);
                pg8::EpiInProj1 E{QA, KA, VA, QB, KB, VB, UC, args.in[4] + l * 64, args.in[5] + l * 64, args.in[6] + l * 64, args.in[7] + l * 64, PSS2};
                pg8::gemm_phase<pg8::EpiInProj1, pg8::StaticOrder, true, true>(L, g, S, E);
#endif
            } else if (sub == 1) {
#ifndef SKIP2A
                { const int per = (1024 + G - 1) / G;
                  for (int i = 0; i < per; ++i) { const int u = vcu * per + i; if (u >= 1024) break; const int bh = u >> 5, qb = u & 31, b = bh >> 3, h = bh & 7;
                      attn_body::attn_unit<8>(b, h, h >> 2, qb, (const attn_body::bf16*)QA, (const attn_body::bf16*)KA, (const attn_body::bf16*)VA, (attn_body::bf16*)QA, (char*)lds); } }
#endif
#ifndef SKIP2B
                { const int per = (512 + G - 1) / G;
                  for (int i = 0; i < per; ++i) { const int u = vcu * per + i; if (u >= 512) break; const int bs = u >> 5, qb = u & 31;
                      attnb::unit(bs >> 2, bs & 3, qb * 256, QB, KB, VB, OB, (LAS char*)L, wid, lane); } }
#endif
                for (int ch = gw; ch < MTOK / 16; ch += NGW) {
                    const int row0 = ch * 16, t0 = row0 & (SEQ - 1), hw = 1 << (lane >> 4);
                    const bf16_t* ub = UC + (size_t)(row0 - t0) * 512 + 8 * lane;
                    u32x4v u[31];
#pragma unroll
                    for (int i = 0; i < 31; ++i) { const int tt = t0 - 8 + i; const bool in = (tt >= 0) && (tt < SEQ); const u32x4v v = *(const u32x4v*)(ub + (size_t)(in ? tt : t0) * 512); u[i] = in ? v : (u32x4v){0u, 0u, 0u, 0u}; }
                    float mk[16];
#pragma unroll
                    for (int d = 0; d < 16; ++d) mk[d] = ((d - 8 >= -hw) && (d - 8 < hw)) ? 1.f : 0.f;
#pragma unroll
                    for (int jj = 0; jj < 16; ++jj) {
                        const int t = t0 + jj, lo = (t - hw < 0) ? 0 : t - hw, hi = (t + hw > SEQ) ? SEQ : t + hw; const float ic = 1.0f / (float)(hi - lo);
                        float sacc[8];
#pragma unroll
                        for (int k = 0; k < 8; ++k) sacc[k] = 0.f;
#pragma unroll
                        for (int d = 0; d < 16; ++d) { const u32x4v v = u[jj + d]; const float mm = mk[d];
                            sacc[0] += mm * bflo(v.x); sacc[1] += mm * bfhi(v.x); sacc[2] += mm * bflo(v.y); sacc[3] += mm * bfhi(v.y); sacc[4] += mm * bflo(v.z); sacc[5] += mm * bfhi(v.z); sacc[6] += mm * bflo(v.w); sacc[7] += mm * bfhi(v.w); }
                        const u32x4v sv = u[jj + 8]; u32x4v o;
                        o.x = pkbf(sacc[0] * ic - bflo(sv.x), sacc[1] * ic - bfhi(sv.x)); o.y = pkbf(sacc[2] * ic - bflo(sv.y), sacc[3] * ic - bfhi(sv.y));
                        o.z = pkbf(sacc[4] * ic - bflo(sv.z), sacc[5] * ic - bfhi(sv.z)); o.w = pkbf(sacc[6] * ic - bflo(sv.w), sacc[7] * ic - bfhi(sv.w));
                        *(u32x4v*)(PC + (size_t)(row0 + jj) * 512 + 8 * lane) = o;
                    }
                }
            } else if (sub == 2) {
                pg8::Gemm g{H, Wl + W_IN + (size_t)3584 * 1024, MTOK, GATEW, 1024}; pg8::StaticOrder S; S.init(MTOK, GATEW, G, bx);
                pg8::EpiGates E{GT, args.in[3] + l * GATEW, PSS2};

#ifndef SKIP3
pg8::gemm_phase<pg8::EpiGates, pg8::StaticOrder, true, true>(L, g, S, E);
#endif

            } else if (sub == 3) {
                pg8::StaticOrder S; S.init(MTOK, DMODEL, G, bx);
#ifndef SKIP4
#pragma unroll 1
                for (int br = 0; br < 3; ++br) {
                    const bf16_t* Ab = (br == 0) ? QA : ((br == 1) ? OB : PC); const bf16_t* Bw = Wl + ((br == 0) ? W_A : ((br == 1) ? W_B : W_C));
                    pg8::Gemm g{Ab, Bw, MTOK, DMODEL, (br == 1) ? 256 : 512}; pg8::EpiMerge E{GT, H, 1024 * br, br == 0};
                    pg8::gemm_phase<pg8::EpiMerge, pg8::StaticOrder, true, true>(L, g, S, E);
                }
#endif
            } else if (sub == 4) {
                pg8::Gemm g{H, Wl + W_O3, MTOK, DMODEL, 1024}; pg8::StaticOrder S; S.init(MTOK, DMODEL, G, bx);

#ifndef SKIP5
pg8::EpiRes E{xcur, xout, XB1, PSS1};
                pg8::gemm_phase<pg8::EpiRes, pg8::StaticOrder, true, true>(L, g, S, E);
#endif

            } else if (sub == 5) {
                pg8::Gemm g{XB1, Wl + W_GU, MTOK, 2 * DFF, 1024}; pg8::StaticOrder S; S.init(MTOK, 2 * DFF, G, bx);
                pg8::EpiFfn1 E{ACT, PSS1};

#ifndef SKIP7
pg8::gemm_phase<pg8::EpiFfn1, pg8::StaticOrder, true, true>(L, g, S, E);
#endif

            } else {
                pg8::Gemm g{ACT, Wl + W_D, MTOK, DMODEL, DFF}; pg8::StaticOrder S; S.init(MTOK, DMODEL, G, bx);

#ifndef SKIP8
pg8::EpiRes E{xout, xout, H, PSS2};
                pg8::gemm_phase<pg8::EpiRes, pg8::StaticOrder, true, true>(L, g, S, E);
#endif

            }
        }
        if (ph + 1 < args.ph_hi) { if (ph == args.ph_lo) grid.sync(); else xcd_barrier(xbar); }
    }
}

__global__ void dbg_dump(const unsigned short* src, float* out, size_t n) {
    for (size_t i = (size_t)blockIdx.x * blockDim.x + threadIdx.x; i < n; i += (size_t)gridDim.x * blockDim.x) out[i] = bf2f(src[i]);
}
#ifndef MK_ONE_LAUNCH
#define MK_ONE_LAUNCH 1
#endif
extern "C" void kernel_launch(void* const* d_in, const int* in_sizes, int n_in, void* d_out, int out_size, void* d_ws, size_t ws_size, hipStream_t stream) {
    static int grid = 0;
    if (grid == 0) {
        int dev = 0, cus = 0, per_cu = 0;
        if (n_in != 18 || out_size != MTOK * DMODEL || ws_size < WS_END) { fprintf(stderr, "kernel_launch: unexpected shapes (n_in %d out %d ws %zu)\n", n_in, out_size, ws_size); grid = -1; return; }
        if (hipGetDevice(&dev) != hipSuccess || hipDeviceGetAttribute(&cus, hipDeviceAttributeMultiprocessorCount, dev) != hipSuccess) { grid = -1; return; }
        if (hipFuncSetAttribute((const void*)encoder_fwd, hipFuncAttributeMaxDynamicSharedMemorySize, LDS_BYTES) != hipSuccess) { fprintf(stderr, "kernel_launch: hipFuncSetAttribute failed\n"); grid = -1; return; }
        if (hipOccupancyMaxActiveBlocksPerMultiprocessor(&per_cu, (const void*)encoder_fwd, NWAVES * 64, LDS_BYTES) != hipSuccess || per_cu < 1) per_cu = 1;
        (void)hipGetLastError();
        grid = cus * per_cu;
    }
    if (grid < 0) return;
    Args a{};
    for (int i = 0; i < 18; ++i) a.in[i] = (const float*)d_in[i];
    a.out = (float*)d_out; a.ws = (unsigned char*)d_ws;
#if MK_ONE_LAUNCH
    (void)hipMemsetAsync(d_ws, 0, 16384, stream);
    a.ph_lo = 0; a.ph_hi = NPHASE;
    void* kargs[] = {&a};
    hipError_t e = hipLaunchCooperativeKernel((const void*)encoder_fwd, dim3(grid), dim3(NWAVES * 64), kargs, LDS_BYTES, stream);
    if (e != hipSuccess) fprintf(stderr, "kernel_launch: cooperative launch failed: %s (grid %d)\n", hipGetErrorString(e), grid);
#else
#ifdef DBG_STOP
    for (int ph = 0; ph < DBG_STOP; ++ph) {
        a.ph_lo = ph; a.ph_hi = ph + 1;
        hipLaunchKernelGGL(encoder_fwd, dim3(grid), dim3(NWAVES * 64), LDS_BYTES, stream, a);
    }
    hipLaunchKernelGGL(dbg_dump, dim3(1024), dim3(256), 0, stream, (const unsigned short*)((unsigned char*)d_ws + DBG_OFF), (float*)d_out, (size_t)MTOK * DMODEL);
#else
    for (int ph = 0; ph < NPHASE; ++ph) {
        a.ph_lo = ph; a.ph_hi = ph + 1;
        hipLaunchKernelGGL(encoder_fwd, dim3(grid), dim3(NWAVES * 64), LDS_BYTES, stream, a);
    }
#endif
#endif
}
```

```cpp
#include <hip/hip_runtime.h>
#include <hip/hip_cooperative_groups.h>
#include <cstdio>
#include <cstdint>
namespace cg = cooperative_groups;
namespace pg8 {
#define PG8_LAS __attribute__((address_space(3)))
typedef unsigned short bf16_t;
typedef short bf16x8 __attribute__((ext_vector_type(8)));
typedef float f32x4 __attribute__((ext_vector_type(4)));
typedef unsigned u32x4 __attribute__((ext_vector_type(4)));
constexpr int BM = 256, BK = 64, HALF = 128, HTB = HALF * BK * 2  , STAGE_BYTES = 8 * HTB, NXCD = 8, WGM = 8;

__host__ __device__ __forceinline__ int lds_byte(int r, int c) { const int st = (r >> 4) * 2 + (c >> 5), rr = r & 15, cc = c & 31, ob = rr * 64 + cc * 2; return st * 1024 + (ob ^ (((ob >> 9) & 1) << 5)); }
__host__ __device__ __forceinline__ void stage_rc(int b, int& R, int& C) { const int st = b / 1024, sb = b % 1024, swz = sb ^ (((sb >> 9) & 1) << 5); R = (st >> 1) * 16 + swz / 64; C = (st & 1) * 32 + (swz % 64) / 2; }
__host__ __device__ __forceinline__ int perm32(int rho) { const int n = rho >> 4, i = rho & 15; return 8 * (i >> 2) + 4 * n + (i & 3); }

struct Unit { int pm, pn; };
struct Gemm { const bf16_t* A; const bf16_t* Bt; int M, N, K; };

struct StaticOrder {
    int nM, nN, nwg, G, c;
    __host__ __device__ void init(int M, int N, int G_, int c_) { nM = M / BM; nN = N / BM; nwg = nM * nN; G = G_; c = c_; }
    __host__ __device__ bool next(int i, Unit& u) const {
        const long L = (long)i * G + c; if (L >= nwg) return false;
        int wgid = (int)L; { const int q = nwg / NXCD, r = nwg % NXCD, xcd = wgid % NXCD, off = wgid / NXCD; wgid = (xcd < r ? xcd * (q + 1) : r * (q + 1) + (xcd - r) * q) + off; }
        const int nig = WGM * nN, gid = wgid / nig, fm = gid * WGM, gsz = (nM - fm) < WGM ? (nM - fm) : WGM;
        u.pm = fm + ((wgid % nig) % gsz); u.pn = (wgid % nig) / gsz; return true;
    }
    __device__ __forceinline__ void a_ready(const Unit&) const {}
    __device__ __forceinline__ void done(const Unit&) const {}
};

typedef float f32x2c __attribute__((ext_vector_type(2))); typedef __bf16 bf16x2c __attribute__((ext_vector_type(2)));
__device__ __forceinline__ unsigned cvt_pk_bf16(float lo, float hi) { f32x2c v = {lo, hi}; bf16x2c b = __builtin_convertvector(v, bf16x2c); return __builtin_bit_cast(unsigned, b); }
typedef float f32x2 __attribute__((ext_vector_type(2)));
template <class Epi, class Sched, bool ALIGN_EPI = false, bool SP2 = false>
__device__ __forceinline__ void gemm_phase(PG8_LAS unsigned char* lds, const Gemm g, const Sched& S, const Epi& E) {
    int tid_raw = threadIdx.x; asm volatile("" : "+v"(tid_raw));
    const int tid = tid_raw, wid = __builtin_amdgcn_readfirstlane(tid >> 6), lane = tid & 63, wr = wid >> 2, wc = wid & 3, fr = lane & 15, fq = lane >> 4;
    const int K = g.K, nt = K / BK;
    unsigned voffA[2], voffB[2];
#pragma unroll
    for (int i = 0; i < 2; ++i) { int R, C; stage_rc(tid * 16 + i * 8192, R, C); const int Rb = Epi::PERM ? ((R & ~31) + perm32(R & 31)) : R;
        voffA[i] = (unsigned)(R * K + C) * 2u; voffB[i] = (unsigned)(Rb * K + C) * 2u; }
    const size_t kstep = (size_t)(BK * 2);
    const size_t hstep = (size_t)HALF * K * 2;
    const size_t tstep = 2 * hstep;
    const unsigned ldsw = (unsigned)wid * 1024u;
    const int aoff = lds_byte(wr * 64 + fr, fq * 8), boff = lds_byte(wc * 32 + fr, fq * 8);
#define PG8_SA(b, h) (((b) * 2 + (h)) * HTB)
#define PG8_SB(b, h) ((4 + (b) * 2 + (h)) * HTB)
#define PG8_STAGE(bufoff, gbase, voff) do { _Pragma("unroll") for (int _i = 0; _i < 2; ++_i) \
        __builtin_amdgcn_global_load_lds((const unsigned*)((const char*)(gbase) + (voff)[_i]), (PG8_LAS unsigned*)(lds + (bufoff) + ldsw + _i * 8192), 16, 0, 0); } while (0)
#define PG8_LDA(dst, b, h) do { _Pragma("unroll") for (int m = 0; m < 4; ++m) _Pragma("unroll") for (int k = 0; k < 2; ++k) dst[m][k] = *(const PG8_LAS bf16x8*)(lds + PG8_SA(b, h) + aoff + m * 2048 + k * 1024); } while (0)
#define PG8_LDB(dst, b, h) do { _Pragma("unroll") for (int n = 0; n < 2; ++n) _Pragma("unroll") for (int k = 0; k < 2; ++k) dst[n][k] = *(const PG8_LAS bf16x8*)(lds + PG8_SB(b, h) + boff + n * 2048 + k * 1024); } while (0)
#define PG8_MMA(ai, bj, At, Bt) do { __builtin_amdgcn_s_setprio(1); _Pragma("unroll") for (int m = 0; m < 4; ++m) _Pragma("unroll") for (int n = 0; n < 2; ++n) _Pragma("unroll") for (int k = 0; k < 2; ++k) \
        acc[ai][bj][m][n] = __builtin_amdgcn_mfma_f32_16x16x32_bf16(Bt[n][k], At[m][k], acc[ai][bj][m][n], 0, 0, 0); __builtin_amdgcn_s_setprio(0); } while (0)
#define PG8_WAIT_V(n) asm volatile("s_waitcnt vmcnt(" #n ")" ::: "memory")
#define PG8_WAIT_L(n) asm volatile("s_waitcnt lgkmcnt(" #n ")" ::: "memory")
#define PG8_BAR __builtin_amdgcn_s_barrier()
#define PG8_SCHED __builtin_amdgcn_sched_barrier(0)
    Unit cur, nxt; int ui = 0;
    if (!S.next(0, cur)) return;
    f32x4 acc[2][2][4][2];
#pragma unroll
    for (int a = 0; a < 2; ++a)
#pragma unroll
        for (int b = 0; b < 2; ++b)
#pragma unroll
            for (int m = 0; m < 4; ++m)
#pragma unroll
                for (int n = 0; n < 2; ++n) acc[a][b][m][n] = (f32x4){0.f, 0.f, 0.f, 0.f};
    bf16x8 At[4][2], B0[2][2], B1[2][2];
    const char* cA = (const char*)g.A + (size_t)cur.pm * tstep; const char* cB = (const char*)g.Bt + (size_t)cur.pn * tstep;
    S.a_ready(cur);
    if constexpr (SP2) {
        PG8_STAGE(PG8_SB(0, 0), cB, voffB); PG8_STAGE(PG8_SB(0, 1), cB + hstep, voffB); PG8_STAGE(PG8_SA(0, 0), cA, voffA); PG8_STAGE(PG8_SA(0, 1), cA + hstep, voffA);
        if (wr == 1) PG8_BAR;
        PG8_WAIT_V(2); PG8_BAR;
        PG8_STAGE(PG8_SB(1, 0), cB + kstep, voffB); PG8_STAGE(PG8_SA(1, 0), cA + kstep, voffA); PG8_STAGE(PG8_SB(1, 1), cB + hstep + kstep, voffB);
        PG8_WAIT_V(6); PG8_BAR;
    } else {
        PG8_STAGE(PG8_SB(0, 0), cB, voffB); PG8_STAGE(PG8_SA(0, 0), cA, voffA); PG8_STAGE(PG8_SB(0, 1), cB + hstep, voffB); PG8_STAGE(PG8_SA(0, 1), cA + hstep, voffA);
        if (wr == 1) PG8_BAR;
        PG8_WAIT_V(4); PG8_BAR;
        PG8_STAGE(PG8_SB(1, 0), cB + kstep, voffB); PG8_STAGE(PG8_SA(1, 0), cA + kstep, voffA); PG8_STAGE(PG8_SB(1, 1), cB + hstep + kstep, voffB);
        PG8_WAIT_V(6); PG8_BAR;
    }
    for (;;) {
        const bool has_next = S.next(ui + 1, nxt);
        const char* nA = has_next ? (const char*)g.A + (size_t)nxt.pm * tstep : cA; const char* nB = has_next ? (const char*)g.Bt + (size_t)nxt.pn * tstep : cB;
        for (int t = 0; t < nt; t += 2) {
            const bool last = (t == nt - 2);
            const char* a1 = cA + (size_t)(t + 1) * kstep;
            const char* a2 = last ? nA : cA + (size_t)(t + 2) * kstep; const char* b2 = last ? nB : cB + (size_t)(t + 2) * kstep;
            const char* a3 = a2 + kstep; const char* b3 = b2 + kstep;
            if (last && has_next) S.a_ready(nxt);
            if constexpr (SP2) {
            PG8_LDB(B0, 0, 0); PG8_LDB(B1, 0, 1); PG8_SCHED; PG8_LDA(At, 0, 0); PG8_STAGE(PG8_SA(1, 1), a1 + hstep, voffA);
            PG8_WAIT_V(8); PG8_WAIT_L(0); PG8_BAR; PG8_MMA(0, 0, At, B0); PG8_MMA(0, 1, At, B1); PG8_BAR; PG8_SCHED;
            PG8_LDA(At, 0, 1); PG8_STAGE(PG8_SB(0, 0), b2, voffB); PG8_STAGE(PG8_SB(0, 1), b2 + hstep, voffB); PG8_STAGE(PG8_SA(0, 0), a2, voffA);
            PG8_WAIT_V(8); PG8_WAIT_L(0); PG8_BAR; PG8_MMA(1, 0, At, B0); PG8_MMA(1, 1, At, B1); PG8_BAR; PG8_SCHED;
            PG8_LDB(B0, 1, 0); PG8_LDB(B1, 1, 1); PG8_SCHED; PG8_LDA(At, 1, 0); PG8_STAGE(PG8_SA(0, 1), a2 + hstep, voffA);
            PG8_WAIT_V(8); PG8_WAIT_L(0); PG8_BAR; PG8_MMA(0, 0, At, B0); PG8_MMA(0, 1, At, B1); PG8_BAR; PG8_SCHED;
            PG8_LDA(At, 1, 1); PG8_STAGE(PG8_SB(1, 0), b3, voffB); PG8_STAGE(PG8_SB(1, 1), b3 + hstep, voffB); PG8_STAGE(PG8_SA(1, 0), a3, voffA);
            PG8_WAIT_V(8); PG8_WAIT_L(0); PG8_BAR; PG8_MMA(1, 0, At, B0); PG8_MMA(1, 1, At, B1); PG8_BAR; PG8_SCHED;
            } else {
            PG8_LDB(B0, 0, 0); PG8_SCHED; PG8_LDA(At, 0, 0); PG8_STAGE(PG8_SA(1, 1), a1 + hstep, voffA);
            PG8_WAIT_L(8); PG8_BAR; PG8_WAIT_L(0); PG8_MMA(0, 0, At, B0); PG8_BAR; PG8_SCHED;
            PG8_LDB(B1, 0, 1); PG8_STAGE(PG8_SB(0, 0), b2, voffB);
            PG8_BAR; PG8_WAIT_L(0); PG8_MMA(0, 1, At, B1); PG8_BAR;
            PG8_LDA(At, 0, 1); PG8_STAGE(PG8_SA(0, 0), a2, voffA);
            PG8_BAR; PG8_WAIT_L(0); PG8_MMA(1, 0, At, B0); PG8_BAR; PG8_SCHED;
            PG8_STAGE(PG8_SB(0, 1), b2 + hstep, voffB);
            PG8_WAIT_V(6); PG8_BAR; PG8_MMA(1, 1, At, B1); PG8_BAR;
            PG8_LDB(B0, 1, 0); PG8_SCHED; PG8_LDA(At, 1, 0); PG8_STAGE(PG8_SA(0, 1), a2 + hstep, voffA);
            PG8_WAIT_L(8); PG8_BAR; PG8_WAIT_L(0); PG8_MMA(0, 0, At, B0); PG8_BAR; PG8_SCHED;
            PG8_LDB(B1, 1, 1); PG8_STAGE(PG8_SB(1, 0), b3, voffB);
            PG8_BAR; PG8_WAIT_L(0); PG8_MMA(0, 1, At, B1); PG8_BAR;
            PG8_LDA(At, 1, 1); PG8_STAGE(PG8_SA(1, 0), a3, voffA);
            PG8_BAR; PG8_WAIT_L(0); PG8_MMA(1, 0, At, B0); PG8_BAR; PG8_SCHED;
            PG8_STAGE(PG8_SB(1, 1), b3 + hstep, voffB);
            PG8_WAIT_V(6); PG8_BAR; PG8_MMA(1, 1, At, B1); PG8_BAR;
            }
        }
        if constexpr (ALIGN_EPI) { if (wr == 0) PG8_BAR; }
        if constexpr (!Epi::AFTER_DRAIN) { E(acc, cur, wr, wc, fr, fq); S.done(cur); }
        if (!has_next) break;
#pragma unroll
        for (int a = 0; a < 2; ++a)
#pragma unroll
            for (int b = 0; b < 2; ++b)
#pragma unroll
                for (int m = 0; m < 4; ++m)
#pragma unroll
                    for (int n = 0; n < 2; ++n) acc[a][b][m][n] = (f32x4){0.f, 0.f, 0.f, 0.f};
        cur = nxt; cA = nA; cB = nB; ++ui;
        if constexpr (ALIGN_EPI) { if (wr == 1) PG8_BAR; }
    }
    PG8_WAIT_V(0);
    if constexpr (!ALIGN_EPI) { if (wr == 0) PG8_BAR; }
    PG8_BAR;
    if constexpr (Epi::AFTER_DRAIN) { E.fused(acc, cur, wr, wc, fr, fq, lds, wid, lane); S.done(cur); }
#undef PG8_SA
#undef PG8_SB
#undef PG8_STAGE
#undef PG8_LDA
#undef PG8_LDB
#undef PG8_MMA
#undef PG8_WAIT_V
#undef PG8_WAIT_L
#undef PG8_BAR
#undef PG8_SCHED
}
}
#include <hip/hip_bf16.h>
#include <cmath>
namespace attn_body {
using bf16=__hip_bfloat16;
using bf16x8=__attribute__((ext_vector_type(8)))short;
using s16x4=__attribute__((ext_vector_type(4)))short;
using f32x16=__attribute__((ext_vector_type(16)))float;
using u32x4=__attribute__((ext_vector_type(4)))unsigned;
constexpr int SEQ=8192,D=64,PQ=512,PKV=128;
constexpr int NW=8,QBLK=32,QB=QBLK*NW,KVBLK=64,NQB=SEQ/QB;
constexpr int ATTN_UNIT_ROWS=QB;
__device__ __forceinline__ int crow(int r,int hi){return (r&3)+8*(r>>2)+4*hi;}
#define SBAR() __builtin_amdgcn_sched_barrier(0)
__device__ __forceinline__ void cmask(f32x16&p0,f32x16&p1,int jb,int qrel,int hi){
  const float NEG=-INFINITY; int kb=64*jb+4*hi;
  #pragma unroll
  for(int r=0;r<16;++r){int kv=kb+(r&3)+8*(r>>2); if(kv>qrel)p0[r]=NEG; if(kv+32>qrel)p1[r]=NEG;}
}

constexpr int NSLOT=3, SLOTB=8192;
constexpr int LDS_K=0, LDS_V=NSLOT*SLOTB, LDS_WS=2*NSLOT*SLOTB, LDS_OST=LDS_WS+NW*64*4, LDS_BYTES=LDS_OST+NW*4096;
constexpr float C2=0.125f*1.4426950408889634f;
__device__ __forceinline__ void glds16(const void*gsrc,unsigned lds_dst){unsigned keep;
  asm volatile("s_mov_b32 %0, m0\n\ts_mov_b32 m0, %2\n\ts_nop 0\n\tglobal_load_lds_dwordx4 %1, off\n\ts_mov_b32 m0, %0":"=&s"(keep):"v"(gsrc),"s"(lds_dst):"memory");}
__device__ __forceinline__ float max3f(float a,float b,float c){float r;asm("v_max3_f32 %0, %1, %2, %3":"=v"(r):"v"(a),"v"(b),"v"(c));return r;}
__device__ __forceinline__ float max2f(float a,float b){float r;asm("v_max_f32_e32 %0, %1, %2":"=v"(r):"v"(a),"v"(b));return r;}
__device__ __forceinline__ float fadd_s(float a,float b){float r;asm("v_add_f32_e32 %0, %1, %2":"=v"(r):"v"(a),"v"(b));return r;}
__device__ __forceinline__ float fsub_s(float a,float b){float r;asm("v_sub_f32_e32 %0, %1, %2":"=v"(r):"v"(a),"v"(b));return r;}
typedef float f32x2_t __attribute__((ext_vector_type(2))); typedef __bf16 bf16x2_t __attribute__((ext_vector_type(2)));
__device__ __forceinline__ unsigned cvtpk_s(float lo,float hi){f32x2_t v={lo,hi};bf16x2_t b=__builtin_convertvector(v,bf16x2_t);return __builtin_bit_cast(unsigned,b);}
#define WAIT_BAR(N) asm volatile("s_waitcnt vmcnt(" #N ") lgkmcnt(0)\n\ts_barrier":::"memory")

__device__ __forceinline__ void qkt(f32x16&p0,f32x16&p1,const char*Kslot,const bf16x8*qr,const f32x16&negm,int r32,int hi){
  const char*kb=Kslot+hi*1024+r32*16;
  #pragma unroll
  for(int d0=0;d0<4;++d0){
    const bf16x8 b0=*reinterpret_cast<const bf16x8*>(kb+d0*2048);
    const bf16x8 b1=*reinterpret_cast<const bf16x8*>(kb+d0*2048+512);
    if(d0==0){p0=__builtin_amdgcn_mfma_f32_32x32x16_bf16(b0,qr[0],negm,0,0,0);p1=__builtin_amdgcn_mfma_f32_32x32x16_bf16(b1,qr[0],negm,0,0,0);}
    else{p0=__builtin_amdgcn_mfma_f32_32x32x16_bf16(b0,qr[d0],p0,0,0,0);p1=__builtin_amdgcn_mfma_f32_32x32x16_bf16(b1,qr[d0],p1,0,0,0);}}
}
typedef __attribute__((address_space(3))) const char* lds_cptr;
typedef short v4i16_t __attribute__((ext_vector_type(4)));
__device__ __forceinline__ void kload8(bf16x8*kf,lds_cptr kp){
  kf[0]=*(const __attribute__((address_space(3))) bf16x8*)(kp);      kf[1]=*(const __attribute__((address_space(3))) bf16x8*)(kp+512);
  kf[2]=*(const __attribute__((address_space(3))) bf16x8*)(kp+2048); kf[3]=*(const __attribute__((address_space(3))) bf16x8*)(kp+2560);
  kf[4]=*(const __attribute__((address_space(3))) bf16x8*)(kp+4096); kf[5]=*(const __attribute__((address_space(3))) bf16x8*)(kp+4608);
  kf[6]=*(const __attribute__((address_space(3))) bf16x8*)(kp+6144); kf[7]=*(const __attribute__((address_space(3))) bf16x8*)(kp+6656);
}
__device__ __forceinline__ void kload2(bf16x8*kf,lds_cptr kp,int j){ kf[2*j]=*(const __attribute__((address_space(3))) bf16x8*)(kp+j*2048); kf[2*j+1]=*(const __attribute__((address_space(3))) bf16x8*)(kp+j*2048+512); }
__device__ __forceinline__ s16x4 vtr(lds_cptr p){ return __builtin_bit_cast(s16x4,__builtin_amdgcn_ds_read_tr16_b64_v4i16((__attribute__((address_space(3))) v4i16_t*)p)); }
__device__ __forceinline__ float rowmax(const f32x16&p0,const f32x16&p1){
  float a=max3f(p0[0],p0[1],p1[0]),b=max3f(p0[2],p0[3],p1[1]);a=max3f(a,p1[2],p1[3]);
  #pragma unroll
  for(int r=4;r<16;r+=4){a=max3f(a,p0[r],p0[r+1]);b=max3f(b,p0[r+2],p0[r+3]);a=max3f(a,p1[r],p1[r+1]);b=max3f(b,p1[r+2],p1[r+3]);}
  const float m=max2f(a,b);
  auto rr=__builtin_amdgcn_permlane32_swap(__float_as_uint(m),__float_as_uint(m),false,false);
  return max2f(__uint_as_float(rr[0]),__uint_as_float(rr[1]));
}
__device__ __forceinline__ void pv(f32x16*o,int vb,bf16x8 pa0,bf16x8 pa1,bf16x8 pa2,bf16x8 pa3){
  #pragma unroll
  for(int d0=0;d0<2;++d0){s16x4 lo[4],hi[4];
    #pragma unroll
    for(int ks=0;ks<4;++ks){
      asm volatile("ds_read_b64_tr_b16 %0,%1 offset:%c2":"=&v"(lo[ks]):"v"(vb),"i"(d0*4096+ks*1024):"memory");
      asm volatile("ds_read_b64_tr_b16 %0,%1 offset:%c2":"=&v"(hi[ks]):"v"(vb),"i"(d0*4096+ks*1024+512):"memory");}
    asm volatile("s_waitcnt lgkmcnt(0)":::"memory");SBAR();
    #define PK(k) (bf16x8){lo[k][0],lo[k][1],lo[k][2],lo[k][3],hi[k][0],hi[k][1],hi[k][2],hi[k][3]}
    o[d0]=__builtin_amdgcn_mfma_f32_32x32x16_bf16(pa0,PK(0),o[d0],0,0,0);
    o[d0]=__builtin_amdgcn_mfma_f32_32x32x16_bf16(pa1,PK(1),o[d0],0,0,0);
    o[d0]=__builtin_amdgcn_mfma_f32_32x32x16_bf16(pa2,PK(2),o[d0],0,0,0);
    o[d0]=__builtin_amdgcn_mfma_f32_32x32x16_bf16(pa3,PK(3),o[d0],0,0,0);
    #undef PK
  }
}

#ifndef ATTN_STORE16
#define ATTN_STORE16(p,v) (*(u32x4*)(p)=(v))
#endif
template<int THRL> __device__ __forceinline__ void attn_unit(int b,int h,int kvh,int qb,const bf16*Q,const bf16*__restrict__ K,const bf16*__restrict__ V,bf16*O,char*shm){
  int tid_raw=threadIdx.x; asm volatile("":"+v"(tid_raw));
  const int tid=tid_raw,lane=tid&63,r32=lane&31,hi=lane>>5; const int wid=__builtin_amdgcn_readfirstlane(tid>>6);
  const long rowbase=(long)b*SEQ; const int q0=qb*QB;
  const bf16*Qw=Q+(rowbase+q0+wid*QBLK)*PQ+h*D;
  const bf16*Kh=K+rowbase*PKV+kvh*D,*Vh=V+rowbase*PKV+kvh*D;
  const unsigned lds0=(unsigned)(uintptr_t)shm;
  float*wsf=(float*)(shm+LDS_WS)+wid*64;
  const bf16*ksrc=Kh+(long)lane*PKV+wid*8;
  const bf16*vsrc=Vh+(long)(16*(wid&3)+(lane>>2))*PKV+(wid>>2)*32+(lane&3)*8;
  const unsigned kdst=lds0+LDS_K+wid*1024, vdst=lds0+LDS_V+wid*1024;
  #define DMA_K(t,slot) glds16(ksrc+(long)(t)*KVBLK*PKV,(unsigned)__builtin_amdgcn_readfirstlane(kdst+(slot)))
  #define DMA_V(t,slot) glds16(vsrc+(long)(t)*KVBLK*PKV,(unsigned)__builtin_amdgcn_readfirstlane(vdst+(slot)))
  const int vb0=(int)(lds0+LDS_V)+((lane>>4)&1)*32+(lane&3)*8+(4*hi+((lane&15)>>2))*64;
  const char*Kbase=shm+LDS_K; bf16x8 kf[8];
  const lds_cptr shm3=(lds_cptr)shm; const lds_cptr kp0=shm3+LDS_K+hi*1024+r32*16; const lds_cptr vp0=shm3+LDS_V+((lane>>4)&1)*32+(lane&3)*8+(4*hi+((lane&15)>>2))*64;
  const int NT=SEQ/KVBLK;
  DMA_K(0,0);DMA_V(0,0);DMA_K(1,SLOTB);
  bf16x8 qr[4];
  #pragma unroll
  for(int d0=0;d0<4;++d0)qr[d0]=*reinterpret_cast<const bf16x8*>(&Qw[(long)r32*PQ+d0*16+hi*8]);
  float mhat=0.f,l_reg=0.f;f32x16 o[2];o[0]=f32x16{};o[1]=f32x16{};f32x16 negm=f32x16{};asm volatile("":"+v"(negm));
  const int qrel=wid*QBLK+r32;
  #define CMASK(P0,P1,t) do{}while(0)
  bool resc=false;
  #define START(P0,P1) do{ const float rm=rowmax(P0,P1); resc=false; \
    { const float dl=rm; mhat=fadd_s(mhat,dl); \
      _Pragma("unroll") for(int r=0;r<16;++r){P0[r]=fsub_s(P0[r],dl);P1[r]=fsub_s(P1[r],dl);} \
      _Pragma("unroll") for(int r=0;r<16;++r)negm[r]=-mhat; asm volatile("":"+v"(negm)); } \
    _Pragma("unroll") for(int r=0;r<16;++r)P0[r]=__builtin_amdgcn_exp2f(P0[r]); }while(0)
  #define RESC() do{ if(resc){ asm volatile("s_waitcnt lgkmcnt(0)":::"memory"); \
      _Pragma("unroll") for(int d_=0;d_<2;++d_) _Pragma("unroll") for(int r=0;r<16;++r)o[d_][r]*=wsf[crow(r,hi)]; } }while(0)
  f32x16 pA0,pA1,pB0,pB1;
  int sl_prev=0,sl_cur=0,sl_next=SLOTB;
  #define ROT() do{sl_prev=sl_cur;sl_cur=sl_next;sl_next=(sl_next==(NSLOT-1)*SLOTB)?0:sl_next+SLOTB;}while(0)
  DMA_K(2,2*SLOTB);
  WAIT_BAR(3);
  qkt(pA0,pA1,Kbase,qr,negm,r32,hi);asm volatile("s_nop 15\n\ts_nop 7":"+v"(pA0),"+v"(pA1));CMASK(pA0,pA1,0);
  START(pA0,pA1);
  _Pragma("unroll") for(int r=0;r<16;++r)pA1[r]=__builtin_amdgcn_exp2f(pA1[r]);
  WAIT_BAR(0);
  DMA_K(3,0);DMA_V(1,SLOTB);
  ROT();
  kload8(kf,kp0+sl_cur);
  WAIT_BAR(2);
  s16x4 vlo[8],vhi[8]; u32x4 pw0,pw1,pw2,pw3;
  #define PKW(P,B) cvtpk_s(P[B],P[B+1])
  #define PAF(k) __builtin_bit_cast(bf16x8,pw##k)
  #define VFR(i) (bf16x8){vlo[i][0],vlo[i][1],vlo[i][2],vlo[i][3],vhi[i][0],vhi[i][1],vhi[i][2],vhi[i][3]}
  #define PIN(x) asm volatile("":"+v"(x))
  #define MX3(a,b,c) __builtin_fmaxf(__builtin_fmaxf((a),(b)),(c))
  #define GAPA(MF,A0,A1,A2,A3,W0,W1,PW) do{ MF; sacc+=A0; sacc+=A1; sacc+=A2; sacc+=A3; PIN(sacc); W0; W1; PIN(PW); SBAR(); }while(0)
  #define EX(v) __builtin_amdgcn_exp2f(v)
  #define GAPB(MF,X,B) do{ MF; X[B]=EX(X[B]); X[B+1]=EX(X[B+1]); X[B+2]=EX(X[B+2]); X[B+3]=EX(X[B+3]); PIN(X); SBAR(); }while(0)
  #define VRD(i) do{ vlo[i]=vtr(vp_+(((i)>>2)*4096+((i)&3)*1024)); vhi[i]=vtr(vp_+(((i)>>2)*4096+((i)&3)*1024+512)); }while(0)
  #define KRD(G,j) do{ if(G){ kload2(kf,kp0+sl_next,j); SBAR(); } }while(0)
  #define STEP(C0,C1,P0,P1,t,GK,GV,GL) do{ SBAR(); \
    const lds_cptr vp_=vp0+sl_prev; \
    VRD(0); SBAR(); float sacc=(P0[0]+P0[1]); \
    GAPA(C0=__builtin_amdgcn_mfma_f32_32x32x16_bf16(kf[0],qr[0],negm,0,0,0), P0[2],P0[3],P0[4],P0[5],     pw0[0]=PKW(P0,0), pw0[1]=PKW(P0,2), pw0); \
    VRD(4); SBAR(); GAPA(C1=__builtin_amdgcn_mfma_f32_32x32x16_bf16(kf[1],qr[0],negm,0,0,0), P0[6],P0[7],P0[8],P0[9],     pw0[2]=PKW(P0,4), pw0[3]=PKW(P0,6), pw0); \
    VRD(1); SBAR(); GAPA(C0=__builtin_amdgcn_mfma_f32_32x32x16_bf16(kf[2],qr[1],C0,0,0,0),   P0[10],P0[11],P0[12],P0[13], pw1[0]=PKW(P0,8), pw1[1]=PKW(P0,10), pw1); \
    VRD(5); SBAR(); GAPA(C1=__builtin_amdgcn_mfma_f32_32x32x16_bf16(kf[3],qr[1],C1,0,0,0),   P0[14],P0[15],P1[0],P1[1],   pw1[2]=PKW(P0,12),pw1[3]=PKW(P0,14), pw1); \
    VRD(2); SBAR(); GAPA(C0=__builtin_amdgcn_mfma_f32_32x32x16_bf16(kf[4],qr[2],C0,0,0,0),   P1[2],P1[3],P1[4],P1[5],     pw2[0]=PKW(P1,0), pw2[1]=PKW(P1,2), pw2); \
    VRD(6); SBAR(); GAPA(C1=__builtin_amdgcn_mfma_f32_32x32x16_bf16(kf[5],qr[2],C1,0,0,0),   P1[6],P1[7],P1[8],P1[9],     pw2[2]=PKW(P1,4), pw2[3]=PKW(P1,6), pw2); \
    VRD(3); SBAR(); GAPA(C0=__builtin_amdgcn_mfma_f32_32x32x16_bf16(kf[6],qr[3],C0,0,0,0),   P1[10],P1[11],P1[12],P1[13], pw3[0]=PKW(P1,8), pw3[1]=PKW(P1,10), pw3); \
    VRD(7); SBAR(); GAPA(C1=__builtin_amdgcn_mfma_f32_32x32x16_bf16(kf[7],qr[3],C1,0,0,0),   P1[14],P1[15],0.f,0.f,       pw3[2]=PKW(P1,12),pw3[3]=PKW(P1,14), pw3); \
    l_reg+=sacc; \
    if(GK){DMA_K((t)+3,sl_cur);} if(GV){DMA_V((t)+1,sl_next);} \
    CMASK(C0,C1,t); \
    { float a=MX3(C0[0],C0[1],C1[0]),b=MX3(C0[2],C0[3],C1[1]); a=MX3(a,C1[2],C1[3]); \
      _Pragma("unroll") for(int r=4;r<16;r+=4){a=MX3(a,C0[r],C0[r+1]);b=MX3(b,C0[r+2],C0[r+3]);a=MX3(a,C1[r],C1[r+1]);b=MX3(b,C1[r+2],C1[r+3]);} \
      float rm=__builtin_fmaxf(a,b); { auto rr=__builtin_amdgcn_permlane32_swap(__float_as_uint(rm),__float_as_uint(rm),false,false); rm=__builtin_fmaxf(__uint_as_float(rr[0]),__uint_as_float(rr[1])); } \
      resc=false; \
      if(__builtin_expect(__any(rm>(float)THRL),0)){ const float dl=__builtin_fmaxf(rm,0.f); mhat+=dl; \
        _Pragma("unroll") for(int r=0;r<16;++r){C0[r]-=dl;C1[r]-=dl;} \
        _Pragma("unroll") for(int r=0;r<16;++r)negm[r]=-mhat; asm volatile("":"+v"(negm)); \
        const float f=__builtin_amdgcn_exp2f(-dl); l_reg*=f; if(hi==0)wsf[r32]=f; resc=true; } } \
    SBAR(); \
    GAPB(o[0]=__builtin_amdgcn_mfma_f32_32x32x16_bf16(PAF(0),VFR(0),o[0],0,0,0), C0,0); \
    GAPB(o[1]=__builtin_amdgcn_mfma_f32_32x32x16_bf16(PAF(0),VFR(4),o[1],0,0,0), C0,4); \
    KRD(GL,0); GAPB(o[0]=__builtin_amdgcn_mfma_f32_32x32x16_bf16(PAF(1),VFR(1),o[0],0,0,0), C0,8); \
    KRD(GL,1); GAPB(o[1]=__builtin_amdgcn_mfma_f32_32x32x16_bf16(PAF(1),VFR(5),o[1],0,0,0), C0,12); \
    KRD(GL,2); GAPB(o[0]=__builtin_amdgcn_mfma_f32_32x32x16_bf16(PAF(2),VFR(2),o[0],0,0,0), C1,0); \
    KRD(GL,3); GAPB(o[1]=__builtin_amdgcn_mfma_f32_32x32x16_bf16(PAF(2),VFR(6),o[1],0,0,0), C1,4); \
    GAPB(o[0]=__builtin_amdgcn_mfma_f32_32x32x16_bf16(PAF(3),VFR(3),o[0],0,0,0), C1,8); \
    GAPB(o[1]=__builtin_amdgcn_mfma_f32_32x32x16_bf16(PAF(3),VFR(7),o[1],0,0,0), C1,12); \
    }while(0)
  int t=1;
  #undef CMASK
  #define CMASK(P0,P1,t) do{}while(0)
  for(;t+5<NT;t+=2){
    STEP(pB0,pB1,pA0,pA1,t,true,true,true);     WAIT_BAR(2); RESC(); ROT();
    STEP(pA0,pA1,pB0,pB1,t+1,true,true,true);   WAIT_BAR(2); RESC(); ROT();
  }
  #undef CMASK
  #define CMASK(P0,P1,t) do{}while(0)
  #define ENDW(tt) do{ if((tt)+3<NT){WAIT_BAR(2);} else if((tt)+2<NT){WAIT_BAR(1);} else {WAIT_BAR(0);} }while(0)
  for(;t+1<NT;t+=2){
    STEP(pB0,pB1,pA0,pA1,t,(t+3<NT),(t+1<NT),(t+1<NT));       ENDW(t);   RESC(); ROT();
    STEP(pA0,pA1,pB0,pB1,t+1,(t+4<NT),(t+2<NT),(t+2<NT));     ENDW(t+1); RESC(); ROT();
  }
  STEP(pB0,pB1,pA0,pA1,NT-1,false,false,false); RESC();
  { float sacc=pB0[0]+pB0[1]; _Pragma("unroll") for(int r=2;r<16;++r)sacc+=pB0[r]; _Pragma("unroll") for(int r=0;r<16;++r)sacc+=pB1[r]; l_reg+=sacc;
    pw0=(u32x4){PKW(pB0,0),PKW(pB0,2),PKW(pB0,4),PKW(pB0,6)};pw1=(u32x4){PKW(pB0,8),PKW(pB0,10),PKW(pB0,12),PKW(pB0,14)};pw2=(u32x4){PKW(pB1,0),PKW(pB1,2),PKW(pB1,4),PKW(pB1,6)};pw3=(u32x4){PKW(pB1,8),PKW(pB1,10),PKW(pB1,12),PKW(pB1,14)};
    SBAR(); pv(o,vb0+sl_cur,PAF(0),PAF(1),PAF(2),PAF(3)); }
  #undef PKW
  #undef PAF
  #undef VFR
  #undef PIN
  #undef MX3
  #undef GAPA
  #undef GAPB
  #undef EX
  #undef VRD
  #undef KRD
  #undef STEP
  #undef ENDW
  {auto rr=__builtin_amdgcn_permlane32_swap(__float_as_uint(l_reg),__float_as_uint(l_reg),false,false);l_reg=__uint_as_float(rr[0])+__uint_as_float(rr[1]);}
  if(hi==0)wsf[32+r32]=l_reg;asm volatile("s_waitcnt lgkmcnt(0)":::"memory");
  float rli[16];
  #pragma unroll
  for(int r=0;r<16;++r)rli[r]=__builtin_amdgcn_rcpf(wsf[32+crow(r,hi)]);
  bf16*Ow=O+(rowbase+q0+wid*QBLK)*PQ+h*D;
  { bf16*stg=(bf16*)(shm+LDS_OST)+wid*2048;
    #pragma unroll
    for(int r=0;r<16;++r){const int orow=crow(r,hi);
      #pragma unroll
      for(int d0=0;d0<2;++d0)stg[orow*64+d0*32+r32]=__float2bfloat16(o[d0][r]*rli[r]);}
    asm volatile("s_waitcnt lgkmcnt(0)":::"memory");
    #pragma unroll
    for(int i=0;i<4;++i){const int row=i*8+(lane>>3),ch=lane&7; const u32x4 v=*(const u32x4*)(stg+row*64+ch*8); ATTN_STORE16(Ow+(long)row*PQ+ch*8,v);} }
  asm volatile("s_waitcnt lgkmcnt(0)\n\ts_barrier":::"memory");
  #undef DMA_K
  #undef DMA_V
  #undef CMASK
  #undef START
  #undef RESC
  #undef ROT
}
constexpr int ATTN_LDS_BYTES=LDS_BYTES;
#undef SBAR
#undef WAIT_BAR
}
#define LAS __attribute__((address_space(3)))
constexpr int SEQ = 8192, BATCH = 4, MTOK = BATCH * SEQ, DMODEL = 1024, DEPTH = 4, DFF = 2816, INW = 6656, GATEW = 3072;
constexpr float RMS_EPS = 1e-6f;
constexpr float QSCALE = 0.125f * 1.4426950408889634f;
constexpr int NWAVES = 8;
typedef pg8::bf16_t bf16_t;
typedef pg8::f32x4 f32x4;
typedef pg8::bf16x8 bf16x8;
typedef unsigned u32x2 __attribute__((ext_vector_type(2)));
typedef unsigned u32x4v __attribute__((ext_vector_type(4)));

constexpr size_t W_IN = 0, W_A = W_IN + (size_t)INW * 1024, W_B = W_A + 1024 * 512, W_C = W_B + 1024 * 256, W_O3 = W_C + 1024 * 512,
                 W_GU = W_O3 + (size_t)1024 * 3072, W_D = W_GU + (size_t)2 * DFF * 1024, W_LAYER = W_D + (size_t)1024 * DFF;
static_assert(W_LAYER * 2 == 38u * 1048576u, "weight block is 38 MiB");
constexpr size_t MiB = 1u << 20;
constexpr size_t WS_W = 1 * MiB, WS_H = 153 * MiB, WS_QA = 217 * MiB, WS_BIG = 249 * MiB, WS_OB = 441 * MiB, WS_PC = 457 * MiB, WS_END = 489 * MiB;
constexpr size_t BIG_KA = 0, BIG_VA = 8 * MiB, BIG_QB = 16 * MiB, BIG_KB = 64 * MiB, BIG_VB = 112 * MiB, BIG_UC = 160 * MiB;
constexpr int LDS_BYTES = 147456;

__device__ __forceinline__ float bf2f(unsigned short h) { return __builtin_bit_cast(float, (unsigned)h << 16); }
__device__ __forceinline__ float bflo(unsigned w) { return __builtin_bit_cast(float, w << 16); }
__device__ __forceinline__ float bfhi(unsigned w) { return __builtin_bit_cast(float, w & 0xffff0000u); }
__device__ __forceinline__ unsigned pkbf(float lo, float hi) { return pg8::cvt_pk_bf16(lo, hi); }
__device__ __forceinline__ int finv(int f) { return (f & ~255) | (((f >> 5) & 1) << 7) | (((f >> 6) & 3) << 5) | (f & 31); }
__device__ __forceinline__ void sincos_rad(float ang, float& s, float& c) { float r = __builtin_amdgcn_fractf(ang * 0.15915494309189535f); s = __builtin_amdgcn_sinf(r); c = __builtin_amdgcn_cosf(r); }
__device__ __forceinline__ float sigmoidf_(float v) { return __builtin_amdgcn_rcpf(1.0f + __builtin_amdgcn_exp2f(-1.4426950408889634f * v)); }

namespace pg8 {
struct EpiInProj1 {
    static constexpr bool PERM = false, AFTER_DRAIN = false;
    bf16_t *QA, *KA, *VA, *QB, *KB, *VB, *UC; const float *qn_a, *kn_a, *qn_b, *kn_b;
    __device__ __forceinline__ void operator()(const f32x4 (&acc)[2][2][4][2], const Unit& u, int wr, int wc, int fr, int fq) const {
        const int f0 = u.pn * BM + wc * 64;
        bf16_t* dst; int ld, mode; const float* gain = nullptr; float osc = 1.f;
        if (f0 < 512) { dst = QA + f0; ld = 512; mode = 1; gain = qn_a; osc = QSCALE; }
        else if (f0 < 640) { dst = KA + (f0 - 512); ld = 128; mode = 1; gain = kn_a; }
        else if (f0 < 768) { dst = VA + (f0 - 640); ld = 128; mode = 0; }
        else if (f0 < 1536) { dst = QB + (f0 - 768); ld = 768; mode = 2; gain = qn_b; osc = QSCALE; }
        else if (f0 < 2304) { dst = KB + (f0 - 1536); ld = 768; mode = 2; gain = kn_b; }
        else if (f0 < 3072) { dst = VB + (f0 - 2304); ld = 768; mode = 0; }
        else { dst = UC + (f0 - 3072); ld = 512; mode = 0; }
        const int row0 = u.pm * BM + wr * 64 + fr;
        if (mode == 0) {
#pragma unroll
            for (int ai = 0; ai < 2; ++ai)
#pragma unroll
                for (int m = 0; m < 4; ++m) { bf16_t* rp = dst + (size_t)(row0 + ai * HALF + m * 16) * ld + 4 * fq;
#pragma unroll
                    for (int bj = 0; bj < 2; ++bj)
#pragma unroll
                        for (int n = 0; n < 2; ++n) { const f32x4 v = acc[ai][bj][m][n]; u32x2 w; w.x = cvt_pk_bf16(v[0], v[1]); w.y = cvt_pk_bf16(v[2], v[3]); *(u32x2*)(rp + 32 * bj + 16 * n) = w; } }
            return;
        }
        f32x4 g[2][2];
#pragma unroll
        for (int bj = 0; bj < 2; ++bj)
#pragma unroll
            for (int n = 0; n < 2; ++n) g[bj][n] = *(const f32x4*)(gain + 32 * bj + 16 * n + 4 * fq);
        float inv[2][4];
        const float L2T = 13.287712379549449f;
#pragma unroll
        for (int n = 0; n < 2; ++n)
#pragma unroll
            for (int j = 0; j < 4; ++j) inv[n][j] = (mode == 2) ? __builtin_amdgcn_exp2f(-(float)(16 * n + 4 * fq + j) * (L2T / 32.f)) : __builtin_amdgcn_exp2f(-(float)(4 * fq + j) * (L2T / 16.f));
#pragma unroll
        for (int ai = 0; ai < 2; ++ai)
#pragma unroll
            for (int m = 0; m < 4; ++m) {
                const int row = row0 + ai * HALF + m * 16; const int t = row & (SEQ - 1);
                float ss = 0.f;
#pragma unroll
                for (int bj = 0; bj < 2; ++bj)
#pragma unroll
                    for (int n = 0; n < 2; ++n) { const f32x4 v = acc[ai][bj][m][n]; ss += (v[0] * v[0] + v[1] * v[1]) + (v[2] * v[2] + v[3] * v[3]); }
                ss += __shfl_xor(ss, 16); ss += __shfl_xor(ss, 32);
                const float rs = __builtin_amdgcn_rsqf(ss * (1.f / 64.f) + RMS_EPS);
                f32x4 y[2][2], o[2][2];
#pragma unroll
                for (int bj = 0; bj < 2; ++bj)
#pragma unroll
                    for (int n = 0; n < 2; ++n) y[bj][n] = acc[ai][bj][m][n] * rs * g[bj][n];
                if (mode == 2) {
                    const float tf = (float)t;
#pragma unroll
                    for (int n = 0; n < 2; ++n)
#pragma unroll
                        for (int j = 0; j < 4; ++j) { float s, c; sincos_rad(tf * inv[n][j], s, c); const float x1 = y[0][n][j], x2 = y[1][n][j]; o[0][n][j] = x1 * c - x2 * s; o[1][n][j] = x2 * c + x1 * s; }
                } else {
#pragma unroll
                    for (int bj = 0; bj < 2; ++bj) { const float pf = (float)(bj == 0 ? (t >> 6) : (t & 63));
#pragma unroll
                        for (int j = 0; j < 4; ++j) { float s, c; sincos_rad(pf * inv[0][j], s, c); const float x1 = y[bj][0][j], x2 = y[bj][1][j]; o[bj][0][j] = x1 * c - x2 * s; o[bj][1][j] = x2 * c + x1 * s; } }
                }
                bf16_t* rp = dst + (size_t)row * ld + 4 * fq;
#pragma unroll
                for (int bj = 0; bj < 2; ++bj)
#pragma unroll
                    for (int n = 0; n < 2; ++n) { const f32x4 v = o[bj][n] * osc; u32x2 w; w.x = cvt_pk_bf16(v[0], v[1]); w.y = cvt_pk_bf16(v[2], v[3]); *(u32x2*)(rp + 32 * bj + 16 * n) = w; }
            }
    }
};
struct EpiGates {
    static constexpr bool PERM = false, AFTER_DRAIN = false;
    bf16_t* G; const float* bias;
    __device__ __forceinline__ void operator()(const f32x4 (&acc)[2][2][4][2], const Unit& u, int wr, int wc, int fr, int fq) const {
        const int row0 = u.pm * BM + wr * 64 + fr, col0 = u.pn * BM + wc * 64 + 4 * fq;
#pragma unroll
        for (int bj = 0; bj < 2; ++bj)
#pragma unroll
            for (int n = 0; n < 2; ++n) { const int col = col0 + 32 * bj + 16 * n; const f32x4 b = *(const f32x4*)(bias + col);
#pragma unroll
                for (int ai = 0; ai < 2; ++ai)
#pragma unroll
                    for (int m = 0; m < 4; ++m) { const f32x4 v = acc[ai][bj][m][n] + b; u32x2 w; w.x = cvt_pk_bf16(sigmoidf_(v[0]), sigmoidf_(v[1])); w.y = cvt_pk_bf16(sigmoidf_(v[2]), sigmoidf_(v[3]));
                        *(u32x2*)(G + (size_t)(row0 + ai * HALF + m * 16) * GATEW + col) = w; } }
    }
};
struct EpiMerge {
    static constexpr bool PERM = false, AFTER_DRAIN = false;
    const bf16_t* G; bf16_t* Mo; int coloff; int first;
    __device__ __forceinline__ void operator()(const f32x4 (&acc)[2][2][4][2], const Unit& u, int wr, int wc, int fr, int fq) const {
        const int row0 = u.pm * BM + wr * 64 + fr, col0 = u.pn * BM + wc * 64 + 4 * fq;
#pragma unroll
        for (int ai = 0; ai < 2; ++ai)
#pragma unroll
            for (int m = 0; m < 4; ++m) { const int row = row0 + ai * HALF + m * 16; const bf16_t* gp = G + (size_t)row * GATEW + coloff + col0; bf16_t* mp = Mo + (size_t)row * DMODEL + col0;
                u32x2 gv[2][2], mv[2][2];
#pragma unroll
                for (int bj = 0; bj < 2; ++bj)
#pragma unroll
                    for (int n = 0; n < 2; ++n) { gv[bj][n] = *(const u32x2*)(gp + 32 * bj + 16 * n); mv[bj][n] = first ? (u32x2){0u, 0u} : *(const u32x2*)(mp + 32 * bj + 16 * n); }
#pragma unroll
                for (int bj = 0; bj < 2; ++bj)
#pragma unroll
                    for (int n = 0; n < 2; ++n) { const f32x4 v = acc[ai][bj][m][n]; const u32x2 gg = gv[bj][n], mm = mv[bj][n]; u32x2 w;
                        w.x = cvt_pk_bf16(bflo(mm.x) + bflo(gg.x) * v[0], bfhi(mm.x) + bfhi(gg.x) * v[1]); w.y = cvt_pk_bf16(bflo(mm.y) + bflo(gg.y) * v[2], bfhi(mm.y) + bfhi(gg.y) * v[3]); *(u32x2*)(mp + 32 * bj + 16 * n) = w; } }
    }
};
struct EpiRes {
    static constexpr bool PERM = false, AFTER_DRAIN = false;
    const float* base; float* out;
    __device__ __forceinline__ void operator()(const f32x4 (&acc)[2][2][4][2], const Unit& u, int wr, int wc, int fr, int fq) const {
        const int row0 = u.pm * BM + wr * 64 + fr, col0 = u.pn * BM + wc * 64 + 4 * fq;
#pragma unroll
        for (int ai = 0; ai < 2; ++ai)
#pragma unroll
            for (int m = 0; m < 4; ++m) { const size_t off = (size_t)(row0 + ai * HALF + m * 16) * DMODEL + col0;
                f32x4 bv[2][2];
#pragma unroll
                for (int bj = 0; bj < 2; ++bj)
#pragma unroll
                    for (int n = 0; n < 2; ++n) bv[bj][n] = *(const f32x4*)(base + off + 32 * bj + 16 * n);
#pragma unroll
                for (int bj = 0; bj < 2; ++bj)
#pragma unroll
                    for (int n = 0; n < 2; ++n) *(f32x4*)(out + off + 32 * bj + 16 * n) = bv[bj][n] + acc[ai][bj][m][n]; }
    }
};
struct EpiFfn1 {
    static constexpr bool PERM = false, AFTER_DRAIN = false;
    bf16_t* ACT;
    __device__ __forceinline__ void operator()(const f32x4 (&acc)[2][2][4][2], const Unit& u, int wr, int wc, int fr, int fq) const {
        const int row0 = u.pm * BM + wr * 64 + fr, col0 = u.pn * HALF + wc * 32 + 4 * fq;
#pragma unroll
        for (int ai = 0; ai < 2; ++ai)
#pragma unroll
            for (int m = 0; m < 4; ++m) { bf16_t* rp = ACT + (size_t)(row0 + ai * HALF + m * 16) * DFF + col0;
#pragma unroll
                for (int n = 0; n < 2; ++n) { const f32x4 gt = acc[ai][0][m][n], up = acc[ai][1][m][n]; f32x4 r;
#pragma unroll
                    for (int j = 0; j < 4; ++j) r[j] = gt[j] * sigmoidf_(gt[j]) * up[j];
                    u32x2 w; w.x = cvt_pk_bf16(r[0], r[1]); w.y = cvt_pk_bf16(r[2], r[3]); *(u32x2*)(rp + 16 * n) = w; } }
    }
};
}

namespace attnb {
typedef short s16x4 __attribute__((ext_vector_type(4)));
typedef short v4i16_t __attribute__((ext_vector_type(4)));
constexpr int PB = 768, VROW = 144, WAVE_LDS = 32 * VROW;
__device__ __forceinline__ s16x4 vtr(LAS const char* p) { return __builtin_bit_cast(s16x4, __builtin_amdgcn_ds_read_tr16_b64_v4i16((LAS v4i16_t*)p)); }

template <int DIL>
__device__ __forceinline__ void group(const bf16_t* __restrict__ Qg, const bf16_t* __restrict__ Kg, const bf16_t* __restrict__ Vg, int t0r, LAS char* vl, int lane, float& m_run, float& l_run, f32x4 (&o)[4]) {
    constexpr int STEP = 16 / DIL, NK = 15 * STEP + 129, NC = (NK + 31) / 32, LD = SEQ / DIL;
    const int fr = lane & 15, fq = lane >> 4;
    const int rr = t0r & (DIL - 1), lk0 = t0r / DIL - 64;
    bf16x8 qf[2];
    { const bf16_t* qp = Qg + (size_t)(t0r + 16 * fr) * PB + 8 * fq; qf[0] = *(const bf16x8*)qp; qf[1] = *(const bf16x8*)(qp + 32); }
    bf16x8 kf[3][2][2], vr[3][4];
#define AB_LOAD(c, B) do { \
        _Pragma("unroll") for (int T = 0; T < 2; ++T) { int lk = lk0 + 32 * (c) + 16 * T + fr; lk = lk < 0 ? 0 : (lk > LD - 1 ? LD - 1 : lk); \
            const bf16_t* kp = Kg + (size_t)(lk * DIL + rr) * PB + 8 * fq; kf[B][T][0] = *(const bf16x8*)kp; kf[B][T][1] = *(const bf16x8*)(kp + 32); } \
        _Pragma("unroll") for (int i = 0; i < 4; ++i) { int lk = lk0 + 32 * (c) + (lane >> 3) + 8 * i; lk = lk < 0 ? 0 : (lk > LD - 1 ? LD - 1 : lk); \
            vr[B][i] = *(const bf16x8*)(Vg + (size_t)(lk * DIL + rr) * PB + 8 * (lane & 7)); } } while (0)
    AB_LOAD(0, 0);
    if (NC > 1) AB_LOAD(1, 1);
    LAS char* vw = vl + (lane >> 3) * VROW + (lane & 7) * 16;
    LAS const char* vrd = vl + (4 * fq + (fr >> 2)) * VROW + (fr & 3) * 8;
#define AB_COMPUTE(c, B) do { \
_Pragma("unroll") \
        for (int i = 0; i < 4; ++i) *(LAS bf16x8*)(vw + 8 * i * VROW) = vr[B][i]; \
        f32x4 s[2]; \
_Pragma("unroll") \
        for (int T = 0; T < 2; ++T) { s[T] = __builtin_amdgcn_mfma_f32_16x16x32_bf16(kf[B][T][0], qf[0], (f32x4){0.f, 0.f, 0.f, 0.f}, 0, 0, 0); s[T] = __builtin_amdgcn_mfma_f32_16x16x32_bf16(kf[B][T][1], qf[1], s[T], 0, 0, 0); } \
        bool ok[2][4]; float mx = -1e30f; \
_Pragma("unroll") \
        for (int T = 0; T < 2; ++T) \
_Pragma("unroll") \
            for (int r = 0; r < 4; ++r) { const int k = 32 * (c) + 16 * T + 4 * fq + r, lk = lk0 + k; ok[T][r] = (lk >= 0) && (lk < LD) && (k >= STEP * fr) && (k <= STEP * fr + 128); \
                mx = fmaxf(mx, ok[T][r] ? s[T][r] : -1e30f); } \
        mx = fmaxf(mx, __shfl_xor(mx, 16)); mx = fmaxf(mx, __shfl_xor(mx, 32)); \
        const float m_new = fmaxf(m_run, mx), alpha = __builtin_amdgcn_exp2f(m_run - m_new); \
        float p[2][4], ps = 0.f; \
_Pragma("unroll") \
        for (int T = 0; T < 2; ++T) \
_Pragma("unroll") \
            for (int r = 0; r < 4; ++r) { p[T][r] = ok[T][r] ? __builtin_amdgcn_exp2f(s[T][r] - m_new) : 0.f; ps += p[T][r]; } \
        l_run = l_run * alpha + ps; m_run = m_new; \
_Pragma("unroll") \
        for (int dt = 0; dt < 4; ++dt) o[dt] = o[dt] * alpha; \
        u32x4v pw; pw.x = pkbf(p[0][0], p[0][1]); pw.y = pkbf(p[0][2], p[0][3]); pw.z = pkbf(p[1][0], p[1][1]); pw.w = pkbf(p[1][2], p[1][3]); \
        const bf16x8 pf = __builtin_bit_cast(bf16x8, pw); \
_Pragma("unroll") \
        for (int dt = 0; dt < 4; ++dt) { const s16x4 v0 = vtr(vrd + dt * 32), v1 = vtr(vrd + 16 * VROW + dt * 32); \
            const bf16x8 vf = (bf16x8){v0[0], v0[1], v0[2], v0[3], v1[0], v1[1], v1[2], v1[3]}; \
            o[dt] = __builtin_amdgcn_mfma_f32_16x16x32_bf16(vf, pf, o[dt], 0, 0, 0); } \
    } while (0)
#pragma unroll 1
    for (int c = 0; c < NC; c += 3) {
        if (c + 2 < NC) AB_LOAD(c + 2, 2);
        AB_COMPUTE(c, 0);
        if (c + 3 < NC) AB_LOAD(c + 3, 0);
        if (c + 1 < NC) AB_COMPUTE(c + 1, 1);
        if (c + 4 < NC) AB_LOAD(c + 4, 1);
        if (c + 2 < NC) AB_COMPUTE(c + 2, 2);
    }
#undef AB_COMPUTE
#undef AB_LOAD
}
__device__ __forceinline__ void unit(int b, int slot, int q0, const bf16_t* QB, const bf16_t* KB, const bf16_t* VB, bf16_t* OB, LAS char* lds, int wid, int lane) {
    LAS char* vl = lds + wid * WAVE_LDS;
    const size_t seq0 = (size_t)b * SEQ * PB;
    const int fr = lane & 15, fq = lane >> 4;
    for (int rs = 0; rs < 2; ++rs) {
        const int t0r = q0 + wid + 8 * rs;
        float m_run = -1e30f, l_run = 0.f; f32x4 o[4];
#pragma unroll
        for (int dt = 0; dt < 4; ++dt) o[dt] = (f32x4){0.f, 0.f, 0.f, 0.f};
        group<1>(QB + seq0 + 0 * 256 + slot * 64, KB + seq0 + 0 * 256 + slot * 64, VB + seq0 + 0 * 256 + slot * 64, t0r, vl, lane, m_run, l_run, o);
        group<4>(QB + seq0 + 1 * 256 + slot * 64, KB + seq0 + 1 * 256 + slot * 64, VB + seq0 + 1 * 256 + slot * 64, t0r, vl, lane, m_run, l_run, o);
        group<16>(QB + seq0 + 2 * 256 + slot * 64, KB + seq0 + 2 * 256 + slot * 64, VB + seq0 + 2 * 256 + slot * 64, t0r, vl, lane, m_run, l_run, o);
        float l = l_run; l += __shfl_xor(l, 16); l += __shfl_xor(l, 32);
        const float il = __builtin_amdgcn_rcpf(l);
        bf16_t* op = OB + ((size_t)b * SEQ + t0r + 16 * fr) * 256 + slot * 64 + 4 * fq;
#pragma unroll
        for (int dt = 0; dt < 4; ++dt) { const f32x4 v = o[dt] * il; u32x2 w; w.x = pkbf(v[0], v[1]); w.y = pkbf(v[2], v[3]); *(u32x2*)(op + 16 * dt) = w; }
    }
}
}

#define RLX_AGENT __ATOMIC_RELAXED, __HIP_MEMORY_SCOPE_AGENT
#define XB_TMO      128
#define XB_XCNT(j)  (256  + 64 * (j))
#define XB_XSUB(j)  (1280 + 64 * (j))
#define XB_XGEN(j)  (2304 + 64 * (j))
#define XB_TOP      3328
#define XB_TOPGEN   3392
#define XCD_BAR_WORDS 3456
#define XB_SPIN_CAP (1u << 18)

__device__ __forceinline__ unsigned xb_ld(unsigned* p)              { return __hip_atomic_load(p, __ATOMIC_RELAXED, __HIP_MEMORY_SCOPE_AGENT); }
__device__ __forceinline__ unsigned xb_add(unsigned* p, unsigned v) { return __hip_atomic_fetch_add(p, v, __ATOMIC_RELAXED, __HIP_MEMORY_SCOPE_AGENT); }
__device__ __forceinline__ unsigned xb_xcc_id() { return (unsigned)__builtin_amdgcn_s_getreg((3 << 11) | 20) & 0xFu; }
#define XB_SPIN(cond, bar) do { unsigned _sp = 0; while (cond) { __builtin_amdgcn_s_sleep(1); \
    if ((++_sp & 255u) == 0u) { if (xb_ld(&(bar)[XB_TMO])) break; if (_sp > XB_SPIN_CAP) { atomicAdd(&(bar)[XB_TMO], 1u); break; } } } } while (0)

struct XcdBarrier {
    unsigned* bar; unsigned x;
    volatile LAS unsigned* st;
};

__device__ __forceinline__ XcdBarrier xcd_barrier_post(unsigned* bar, volatile LAS unsigned* st) {
    XcdBarrier b; b.bar = bar; b.x = xb_xcc_id(); b.st = st;
    if (threadIdx.x == 0) (void)xb_add(&bar[XB_XCNT(b.x)], 1u);
    return b;
}
__device__ __forceinline__ void xcd_barrier_complete(unsigned* bar, unsigned x, unsigned& nloc, unsigned& nx) {
    const unsigned G = gridDim.x * gridDim.y * gridDim.z;
    unsigned sum, cnt, mine, sp = 0u;
    for (;;) {
        sum = 0u; cnt = 0u; mine = 0u;
#pragma unroll
        for (unsigned j = 0; j < 16; ++j) { const unsigned c = xb_ld(&bar[XB_XCNT(j)]); sum += c; cnt += (c > 0u) ? 1u : 0u; mine = (j == x) ? c : mine; }
        if (sum == G) break;
        __builtin_amdgcn_s_sleep(1);
        if ((++sp & 255u) == 0u) { if (xb_ld(&bar[XB_TMO])) break; if (sp > XB_SPIN_CAP) { atomicAdd(&bar[XB_TMO], 1u); break; } }
    }
    nloc = mine > 0u ? mine : 1u; nx = cnt > 0u ? cnt : 1u;
}

__device__ __forceinline__ void xcd_barrier(const XcdBarrier& b) {
    asm volatile("s_waitcnt vmcnt(0)" ::: "memory");
    __syncthreads();
    if (threadIdx.x == 0) {
        unsigned* bar = b.bar;
        __builtin_amdgcn_s_waitcnt(0);
        unsigned nloc = b.st[0], nx = b.st[1];
        if (nloc == 0u) { xcd_barrier_complete(bar, b.x, nloc, nx); b.st[0] = nloc; b.st[1] = nx; }
        const unsigned old = xb_add(&bar[XB_XSUB(b.x)], 1u);
        const unsigned gen = old / nloc;
        if (old + 1u == (gen + 1u) * nloc) {
            __builtin_amdgcn_fence(__ATOMIC_RELEASE, "agent");
            asm volatile("s_waitcnt vmcnt(0)" ::: "memory");
            const unsigned og = xb_add(&bar[XB_TOP], 1u);
            const unsigned tg = og / nx;
            if (og + 1u == (tg + 1u) * nx) xb_add(&bar[XB_TOPGEN], 1u);
            else XB_SPIN(xb_ld(&bar[XB_TOPGEN]) == tg, bar);
            __builtin_amdgcn_fence(__ATOMIC_ACQUIRE, "agent");
            xb_add(&bar[XB_XGEN(b.x)], 1u);
            asm volatile("s_waitcnt vmcnt(0)" ::: "memory");
        } else {
            XB_SPIN(xb_ld(&bar[XB_XGEN(b.x)]) == gen, bar);
            __builtin_amdgcn_fence(__ATOMIC_ACQUIRE, "agent");
            asm volatile("s_waitcnt vmcnt(0)" ::: "memory");
        }
    }
    __syncthreads();
}

struct Args { const float* in[18]; float* out; unsigned char* ws; int ph_lo, ph_hi; };
constexpr int NPHASE = 1 + 9 * DEPTH;

__device__ __forceinline__ float wave_sum(float v) {
#pragma unroll
    for (int o = 1; o < 64; o <<= 1) v += __shfl_xor(v, o);
    return v;
}
__device__ __forceinline__ void tr_item(const float* __restrict__ W, int ldn, int k0, int n0, bf16_t* __restrict__ dst, int dld, int prow0, int dk0, int ncopy, int dkstride, LAS float* scr, int lane) {
#pragma unroll 8
    for (int i = 0; i < 32; ++i) { const int kk = 2 * i + (lane >> 5); scr[kk * 33 + (lane & 31)] = W[(size_t)(k0 + kk) * ldn + n0 + (lane & 31)]; }
    asm volatile("s_waitcnt lgkmcnt(0)" ::: "memory");
    const int c = lane & 7;
#pragma unroll
    for (int j = 0; j < 4; ++j) { const int n = (lane >> 3) + 8 * j; const LAS float* s = scr + (8 * c) * 33 + n;
        u32x4v o; o.x = pkbf(s[0 * 33], s[1 * 33]); o.y = pkbf(s[2 * 33], s[3 * 33]); o.z = pkbf(s[4 * 33], s[5 * 33]); o.w = pkbf(s[6 * 33], s[7 * 33]);
        for (int cp = 0; cp < ncopy; ++cp) *(u32x4v*)(dst + (size_t)(prow0 + n) * dld + dk0 + cp * dkstride + k0 + 8 * c) = o; }
    asm volatile("s_waitcnt lgkmcnt(0)" ::: "memory");
}

__global__ void __launch_bounds__(NWAVES * 64, 2) encoder_fwd(Args args) {
    extern __shared__ __attribute__((aligned(16))) unsigned char lds[];
    LAS unsigned char* L = (LAS unsigned char*)lds;
    const int G = gridDim.x, bx = blockIdx.x, vcu = (G % 8 == 0) ? (bx % 8) * (G / 8) + bx / 8 : bx;
    const int NGW = G * NWAVES;
    unsigned char* ws = args.ws;
    bf16_t* Wall = (bf16_t*)(ws + WS_W);
    bf16_t* H = (bf16_t*)(ws + WS_H); bf16_t* QA = (bf16_t*)(ws + WS_QA); unsigned char* BIG = ws + WS_BIG;
    bf16_t* KA = (bf16_t*)(BIG + BIG_KA); bf16_t* VA = (bf16_t*)(BIG + BIG_VA); bf16_t* QB = (bf16_t*)(BIG + BIG_QB); bf16_t* KB = (bf16_t*)(BIG + BIG_KB);
    bf16_t* VB = (bf16_t*)(BIG + BIG_VB); bf16_t* UC = (bf16_t*)(BIG + BIG_UC); bf16_t* GT = (bf16_t*)BIG; bf16_t* ACT = (bf16_t*)BIG;
    bf16_t* OB = (bf16_t*)(ws + WS_OB); bf16_t* PC = (bf16_t*)(ws + WS_PC);
    const float* xin = args.in[0]; float* xout = args.out;
    cg::grid_group grid = cg::this_grid();
    volatile LAS unsigned* bst = (volatile LAS unsigned*)(L + 131072 + 64);
    if (threadIdx.x < 2) bst[threadIdx.x] = 0u;
    __syncthreads();
    const XcdBarrier xbar = xcd_barrier_post((unsigned*)ws, bst);

    for (int ph = args.ph_lo; ph < args.ph_hi; ++ph) {
        int tid_raw = threadIdx.x; asm volatile("" : "+v"(tid_raw));
        const int tid = tid_raw, lane = tid & 63, wid = __builtin_amdgcn_readfirstlane(tid >> 6), gw = vcu * NWAVES + wid; (void)tid;
        if (ph == 0) {
            LAS float* scr = (LAS float*)(L + wid * 16384);
            constexpr int I_IN = 16 * 208, I_A = 8 * 32, I_B = 4 * 32, I_O = 16 * 32, I_G = 16 * 88, I_D = 44 * 32, NIT = I_IN + I_A + I_B + I_O + 2 * I_G + I_D;
            for (int it = gw; it < DEPTH * NIT; it += NGW) {
                const int l = it / NIT; int r = it % NIT; bf16_t* Wl = Wall + (size_t)l * W_LAYER;
                if (r < I_IN) { const int kb = r / 208, nb = r % 208; tr_item(args.in[2] + (size_t)l * 1024 * INW, INW, 64 * kb, 32 * nb, Wl + W_IN, 1024, finv(32 * nb), 0, 1, 0, scr, lane); continue; } r -= I_IN;
                if (r < I_A) { const int kb = r / 32, nb = r % 32; tr_item(args.in[10] + (size_t)l * 512 * 1024, 1024, 64 * kb, 32 * nb, Wl + W_A, 512, finv(32 * nb), 0, 1, 0, scr, lane); continue; } r -= I_A;
                if (r < I_B) { const int kb = r / 32, nb = r % 32; tr_item(args.in[11] + (size_t)l * 256 * 1024, 1024, 64 * kb, 32 * nb, Wl + W_B, 256, finv(32 * nb), 0, 1, 0, scr, lane); continue; } r -= I_B;
                if (r < I_O) { const int kb = r / 32, nb = r % 32; tr_item(args.in[13] + (size_t)l * 1024 * 1024, 1024, 64 * kb, 32 * nb, Wl + W_O3, 1024, finv(32 * nb), 0, 1, 0, scr, lane); continue; } r -= I_O;
                if (r < 2 * I_G) { const int up = r >= I_G; if (up) r -= I_G; const int kb = r / 88, nb = r % 88;
                    tr_item(args.in[up ? 16 : 15] + (size_t)l * 1024 * DFF, DFF, 64 * kb, 32 * nb, Wl + W_GU, 1024, finv(256 * (nb >> 2) + 64 * (nb & 3) + 32 * up), 0, 1, 0, scr, lane); continue; } r -= 2 * I_G;
                { const int kb = r / 32, nb = r % 32; tr_item(args.in[17] + (size_t)l * DFF * 1024, 1024, 64 * kb, 32 * nb, Wl + W_D, DFF, finv(32 * nb), 0, 1, 0, scr, lane); }
            }
            for (int it = gw; it < DEPTH * 64 * 16; it += NGW) {
                const int l = it / 1024, c8 = (it >> 4) & 63, nb = it & 15, g = c8 >> 4, n = 64 * nb + lane;
                const float* lin = args.in[8] + ((size_t)l * 4 + g) * 128 * 128 + (size_t)((8 * c8) & 127) * 128;
                const float* sc = args.in[9] + l * 512 + 128 * g;
                const float* wc = args.in[12] + ((size_t)l * 512 + 128 * g) * 1024 + n;
                float a[8];
#pragma unroll
                for (int cc = 0; cc < 8; ++cc) a[cc] = 0.f;
                for (int d = 0; d < 128; ++d) { const float w = wc[(size_t)d * 1024] * sc[d];
#pragma unroll
                    for (int cc = 0; cc < 8; ++cc) a[cc] += lin[cc * 128 + d] * w; }
                u32x4v o; o.x = pkbf(a[0], a[1]); o.y = pkbf(a[2], a[3]); o.z = pkbf(a[4], a[5]); o.w = pkbf(a[6], a[7]);
                *(u32x4v*)(Wall + (size_t)l * W_LAYER + W_C + (size_t)finv(n) * 512 + 8 * c8) = o;
            }
        } else {
            const int l = (ph - 1) / 9, sub = (ph - 1) % 9;
            const bf16_t* Wl = Wall + (size_t)l * W_LAYER;
            const float* xcur = (l == 0) ? xin : xout;
            if (sub == 0 || sub == 6) {
                const float* xs = (sub == 0) ? xcur : xout; const float* gn = args.in[sub == 0 ? 1 : 14] + l * DMODEL;
                f32x4 gv[4];
#pragma unroll
                for (int j = 0; j < 4; ++j) gv[j] = *((const f32x4*)gn + lane + 64 * j);
                for (int m = gw; m < MTOK; m += NGW) {
                    const f32x4* xr = (const f32x4*)(xs + (size_t)m * DMODEL) + lane; f32x4 v[4]; float s = 0.f;
#pragma unroll
                    for (int j = 0; j < 4; ++j) { v[j] = xr[64 * j]; s += (v[j][0] * v[j][0] + v[j][1] * v[j][1]) + (v[j][2] * v[j][2] + v[j][3] * v[j][3]); }
                    const float rs = __builtin_amdgcn_rsqf(wave_sum(s) * (1.f / DMODEL) + RMS_EPS);
                    u32x2* o8 = (u32x2*)(H + (size_t)m * DMODEL) + lane;
#pragma unroll
                    for (int j = 0; j < 4; ++j) { const f32x4 y = v[j] * rs * gv[j]; u32x2 w; w.x = pkbf(y[0], y[1]); w.y = pkbf(y[2], y[3]); o8[64 * j] = w; }
                }
            } else if (sub == 1) {
#ifndef SKIP1
                pg8::Gemm g{H, Wl + W_IN, MTOK, 3584, 1024}; pg8::StaticOrder S; S.init(MTOK, 3584, G, bx);
                pg8::EpiInProj1 E{QA, KA, VA, QB, KB, VB, UC, args.in[4] + l * 64, args.in[5] + l * 64, args.in[6] + l * 64, args.in[7] + l * 64};
                pg8::gemm_phase<pg8::EpiInProj1, pg8::StaticOrder, true, true>(L, g, S, E);
#endif
            } else if (sub == 2) {
#ifndef SKIP2A
                { const int per = (1024 + G - 1) / G;
                  for (int i = 0; i < per; ++i) { const int u = vcu * per + i; if (u >= 1024) break; const int bh = u >> 5, qb = u & 31, b = bh >> 3, h = bh & 7;
                      attn_body::attn_unit<8>(b, h, h >> 2, qb, (const attn_body::bf16*)QA, (const attn_body::bf16*)KA, (const attn_body::bf16*)VA, (attn_body::bf16*)QA, (char*)lds); } }
#endif
#ifndef SKIP2B
                { const int per = (512 + G - 1) / G;
                  for (int i = 0; i < per; ++i) { const int u = vcu * per + i; if (u >= 512) break; const int bs = u >> 5, qb = u & 31;
                      attnb::unit(bs >> 2, bs & 3, qb * 256, QB, KB, VB, OB, (LAS char*)L, wid, lane); } }
#endif
                for (int ch = gw; ch < MTOK / 16; ch += NGW) {
                    const int row0 = ch * 16, t0 = row0 & (SEQ - 1), hw = 1 << (lane >> 4);
                    const bf16_t* ub = UC + (size_t)(row0 - t0) * 512 + 8 * lane;
                    u32x4v u[31];
#pragma unroll
                    for (int i = 0; i < 31; ++i) { const int tt = t0 - 8 + i; const bool in = (tt >= 0) && (tt < SEQ); const u32x4v v = *(const u32x4v*)(ub + (size_t)(in ? tt : t0) * 512); u[i] = in ? v : (u32x4v){0u, 0u, 0u, 0u}; }
                    float mk[16];
#pragma unroll
                    for (int d = 0; d < 16; ++d) mk[d] = ((d - 8 >= -hw) && (d - 8 < hw)) ? 1.f : 0.f;
#pragma unroll
                    for (int jj = 0; jj < 16; ++jj) {
                        const int t = t0 + jj, lo = (t - hw < 0) ? 0 : t - hw, hi = (t + hw > SEQ) ? SEQ : t + hw; const float ic = 1.0f / (float)(hi - lo);
                        float sacc[8];
#pragma unroll
                        for (int k = 0; k < 8; ++k) sacc[k] = 0.f;
#pragma unroll
                        for (int d = 0; d < 16; ++d) { const u32x4v v = u[jj + d]; const float mm = mk[d];
                            sacc[0] += mm * bflo(v.x); sacc[1] += mm * bfhi(v.x); sacc[2] += mm * bflo(v.y); sacc[3] += mm * bfhi(v.y); sacc[4] += mm * bflo(v.z); sacc[5] += mm * bfhi(v.z); sacc[6] += mm * bflo(v.w); sacc[7] += mm * bfhi(v.w); }
                        const u32x4v sv = u[jj + 8]; u32x4v o;
                        o.x = pkbf(sacc[0] * ic - bflo(sv.x), sacc[1] * ic - bfhi(sv.x)); o.y = pkbf(sacc[2] * ic - bflo(sv.y), sacc[3] * ic - bfhi(sv.y));
                        o.z = pkbf(sacc[4] * ic - bflo(sv.z), sacc[5] * ic - bfhi(sv.z)); o.w = pkbf(sacc[6] * ic - bflo(sv.w), sacc[7] * ic - bfhi(sv.w));
                        *(u32x4v*)(PC + (size_t)(row0 + jj) * 512 + 8 * lane) = o;
                    }
                }
            } else if (sub == 3) {
                pg8::Gemm g{H, Wl + W_IN + (size_t)3584 * 1024, MTOK, GATEW, 1024}; pg8::StaticOrder S; S.init(MTOK, GATEW, G, bx);
                pg8::EpiGates E{GT, args.in[3] + l * GATEW};

#ifndef SKIP3
pg8::gemm_phase<pg8::EpiGates, pg8::StaticOrder, true, true>(L, g, S, E);
#endif

            } else if (sub == 4) {
                pg8::StaticOrder S; S.init(MTOK, DMODEL, G, bx);
#ifndef SKIP4
#pragma unroll 1
                for (int br = 0; br < 3; ++br) {
                    const bf16_t* Ab = (br == 0) ? QA : ((br == 1) ? OB : PC); const bf16_t* Bw = Wl + ((br == 0) ? W_A : ((br == 1) ? W_B : W_C));
                    pg8::Gemm g{Ab, Bw, MTOK, DMODEL, (br == 1) ? 256 : 512}; pg8::EpiMerge E{GT, H, 1024 * br, br == 0};
                    pg8::gemm_phase<pg8::EpiMerge, pg8::StaticOrder, true, true>(L, g, S, E);
                }
#endif
            } else if (sub == 5) {
                pg8::Gemm g{H, Wl + W_O3, MTOK, DMODEL, 1024}; pg8::StaticOrder S; S.init(MTOK, DMODEL, G, bx);

#ifndef SKIP5
pg8::EpiRes E{xcur, xout};
                pg8::gemm_phase<pg8::EpiRes, pg8::StaticOrder, true, true>(L, g, S, E);
#endif

            } else if (sub == 7) {
                pg8::Gemm g{H, Wl + W_GU, MTOK, 2 * DFF, 1024}; pg8::StaticOrder S; S.init(MTOK, 2 * DFF, G, bx);
                pg8::EpiFfn1 E{ACT};

#ifndef SKIP7
pg8::gemm_phase<pg8::EpiFfn1, pg8::StaticOrder, true, true>(L, g, S, E);
#endif

            } else {
                pg8::Gemm g{ACT, Wl + W_D, MTOK, DMODEL, DFF}; pg8::StaticOrder S; S.init(MTOK, DMODEL, G, bx);

#ifndef SKIP8
pg8::EpiRes E{xout, xout};
                pg8::gemm_phase<pg8::EpiRes, pg8::StaticOrder, true, true>(L, g, S, E);
#endif

            }
        }
        if (ph + 1 < args.ph_hi) { if (ph == args.ph_lo) grid.sync(); else xcd_barrier(xbar); }
    }
}

__global__ void dbg_dump(const unsigned short* src, float* out, size_t n) {
    for (size_t i = (size_t)blockIdx.x * blockDim.x + threadIdx.x; i < n; i += (size_t)gridDim.x * blockDim.x) out[i] = bf2f(src[i]);
}
#ifndef MK_ONE_LAUNCH
#define MK_ONE_LAUNCH 1
#endif
extern "C" void kernel_launch(void* const* d_in, const int* in_sizes, int n_in, void* d_out, int out_size, void* d_ws, size_t ws_size, hipStream_t stream) {
    static int grid = 0;
    if (grid == 0) {
        int dev = 0, cus = 0, per_cu = 0;
        if (n_in != 18 || out_size != MTOK * DMODEL || ws_size < WS_END) { fprintf(stderr, "kernel_launch: unexpected shapes (n_in %d out %d ws %zu)\n", n_in, out_size, ws_size); grid = -1; return; }
        if (hipGetDevice(&dev) != hipSuccess || hipDeviceGetAttribute(&cus, hipDeviceAttributeMultiprocessorCount, dev) != hipSuccess) { grid = -1; return; }
        if (hipFuncSetAttribute((const void*)encoder_fwd, hipFuncAttributeMaxDynamicSharedMemorySize, LDS_BYTES) != hipSuccess) { fprintf(stderr, "kernel_launch: hipFuncSetAttribute failed\n"); grid = -1; return; }
        if (hipOccupancyMaxActiveBlocksPerMultiprocessor(&per_cu, (const void*)encoder_fwd, NWAVES * 64, LDS_BYTES) != hipSuccess || per_cu < 1) per_cu = 1;
        (void)hipGetLastError();
        grid = cus * per_cu;
    }
    if (grid < 0) return;
    Args a{};
    for (int i = 0; i < 18; ++i) a.in[i] = (const float*)d_in[i];
    a.out = (float*)d_out; a.ws = (unsigned char*)d_ws;
#if MK_ONE_LAUNCH
    (void)hipMemsetAsync(d_ws, 0, 16384, stream);
    a.ph_lo = 0; a.ph_hi = NPHASE;
    void* kargs[] = {&a};
    hipError_t e = hipLaunchCooperativeKernel((const void*)encoder_fwd, dim3(grid), dim3(NWAVES * 64), kargs, LDS_BYTES, stream);
    if (e != hipSuccess) fprintf(stderr, "kernel_launch: cooperative launch failed: %s (grid %d)\n", hipGetErrorString(e), grid);
#else
#ifdef DBG_STOP
    for (int ph = 0; ph < DBG_STOP; ++ph) {
        a.ph_lo = ph; a.ph_hi = ph + 1;
        hipLaunchKernelGGL(encoder_fwd, dim3(grid), dim3(NWAVES * 64), LDS_BYTES, stream, a);
    }
    hipLaunchKernelGGL(dbg_dump, dim3(1024), dim3(256), 0, stream, (const unsigned short*)((unsigned char*)d_ws + DBG_OFF), (float*)d_out, (size_t)MTOK * DMODEL);
#else
    for (int ph = 0; ph < NPHASE; ++ph) {
        a.ph_lo = ph; a.ph_hi = ph + 1;
        hipLaunchKernelGGL(encoder_fwd, dim3(grid), dim3(NWAVES * 64), LDS_BYTES, stream, a);
    }
#endif
#endif
}
```

```cpp
#include <hip/hip_runtime.h>
#include <hip/hip_cooperative_groups.h>
#include <cstdio>
#include <cstdint>
namespace cg = cooperative_groups;
namespace pg8 {
#define PG8_LAS __attribute__((address_space(3)))
typedef unsigned short bf16_t;
typedef short bf16x8 __attribute__((ext_vector_type(8)));
typedef float f32x4 __attribute__((ext_vector_type(4)));
typedef unsigned u32x4 __attribute__((ext_vector_type(4)));
constexpr int BM = 256, BK = 64, HALF = 128, HTB = HALF * BK * 2  , STAGE_BYTES = 8 * HTB, NXCD = 8, WGM = 8;

__host__ __device__ __forceinline__ int lds_byte(int r, int c) { const int st = (r >> 4) * 2 + (c >> 5), rr = r & 15, cc = c & 31, ob = rr * 64 + cc * 2; return st * 1024 + (ob ^ (((ob >> 9) & 1) << 5)); }
__host__ __device__ __forceinline__ void stage_rc(int b, int& R, int& C) { const int st = b / 1024, sb = b % 1024, swz = sb ^ (((sb >> 9) & 1) << 5); R = (st >> 1) * 16 + swz / 64; C = (st & 1) * 32 + (swz % 64) / 2; }
__host__ __device__ __forceinline__ int perm32(int rho) { const int n = rho >> 4, i = rho & 15; return 8 * (i >> 2) + 4 * n + (i & 3); }

struct Unit { int pm, pn; };
struct Gemm { const bf16_t* A; const bf16_t* Bt; int M, N, K; };

struct StaticOrder {
    int nM, nN, nwg, G, c;
    __host__ __device__ void init(int M, int N, int G_, int c_) { nM = M / BM; nN = N / BM; nwg = nM * nN; G = G_; c = c_; }
    __host__ __device__ bool next(int i, Unit& u) const {
        const long L = (long)i * G + c; if (L >= nwg) return false;
        int wgid = (int)L; { const int q = nwg / NXCD, r = nwg % NXCD, xcd = wgid % NXCD, off = wgid / NXCD; wgid = (xcd < r ? xcd * (q + 1) : r * (q + 1) + (xcd - r) * q) + off; }
        const int nig = WGM * nN, gid = wgid / nig, fm = gid * WGM, gsz = (nM - fm) < WGM ? (nM - fm) : WGM;
        u.pm = fm + ((wgid % nig) % gsz); u.pn = (wgid % nig) / gsz; return true;
    }
    __device__ __forceinline__ void a_ready(const Unit&) const {}
    __device__ __forceinline__ void done(const Unit&) const {}
};

typedef float f32x2c __attribute__((ext_vector_type(2))); typedef __bf16 bf16x2c __attribute__((ext_vector_type(2)));
__device__ __forceinline__ unsigned cvt_pk_bf16(float lo, float hi) { f32x2c v = {lo, hi}; bf16x2c b = __builtin_convertvector(v, bf16x2c); return __builtin_bit_cast(unsigned, b); }
typedef float f32x2 __attribute__((ext_vector_type(2)));
template <class Epi, class Sched, bool ALIGN_EPI = false, bool SP2 = false>
__device__ __forceinline__ void gemm_phase(PG8_LAS unsigned char* lds, const Gemm g, const Sched& S, const Epi& E) {
    int tid_raw = threadIdx.x; asm volatile("" : "+v"(tid_raw));
    const int tid = tid_raw, wid = __builtin_amdgcn_readfirstlane(tid >> 6), lane = tid & 63, wr = wid >> 2, wc = wid & 3, fr = lane & 15, fq = lane >> 4;
    const int K = g.K, nt = K / BK;
    unsigned voffA[2], voffB[2];
#pragma unroll
    for (int i = 0; i < 2; ++i) { int R, C; stage_rc(tid * 16 + i * 8192, R, C); const int Rb = Epi::PERM ? ((R & ~31) + perm32(R & 31)) : R;
        voffA[i] = (unsigned)(R * K + C) * 2u; voffB[i] = (unsigned)(Rb * K + C) * 2u; }
    const size_t kstep = (size_t)(BK * 2);
    const size_t hstep = (size_t)HALF * K * 2;
    const size_t tstep = 2 * hstep;
    const unsigned ldsw = (unsigned)wid * 1024u;
    const int aoff = lds_byte(wr * 64 + fr, fq * 8), boff = lds_byte(wc * 32 + fr, fq * 8);
#define PG8_SA(b, h) (((b) * 2 + (h)) * HTB)
#define PG8_SB(b, h) ((4 + (b) * 2 + (h)) * HTB)
#define PG8_STAGE(bufoff, gbase, voff) do { _Pragma("unroll") for (int _i = 0; _i < 2; ++_i) \
        __builtin_amdgcn_global_load_lds((const unsigned*)((const char*)(gbase) + (voff)[_i]), (PG8_LAS unsigned*)(lds + (bufoff) + ldsw + _i * 8192), 16, 0, 0); } while (0)
#define PG8_LDA(dst, b, h) do { _Pragma("unroll") for (int m = 0; m < 4; ++m) _Pragma("unroll") for (int k = 0; k < 2; ++k) dst[m][k] = *(const PG8_LAS bf16x8*)(lds + PG8_SA(b, h) + aoff + m * 2048 + k * 1024); } while (0)
#define PG8_LDB(dst, b, h) do { _Pragma("unroll") for (int n = 0; n < 2; ++n) _Pragma("unroll") for (int k = 0; k < 2; ++k) dst[n][k] = *(const PG8_LAS bf16x8*)(lds + PG8_SB(b, h) + boff + n * 2048 + k * 1024); } while (0)
#define PG8_MMA(ai, bj, At, Bt) do { __builtin_amdgcn_s_setprio(1); _Pragma("unroll") for (int m = 0; m < 4; ++m) _Pragma("unroll") for (int n = 0; n < 2; ++n) _Pragma("unroll") for (int k = 0; k < 2; ++k) \
        acc[ai][bj][m][n] = __builtin_amdgcn_mfma_f32_16x16x32_bf16(Bt[n][k], At[m][k], acc[ai][bj][m][n], 0, 0, 0); __builtin_amdgcn_s_setprio(0); } while (0)
#define PG8_WAIT_V(n) asm volatile("s_waitcnt vmcnt(" #n ")" ::: "memory")
#define PG8_WAIT_L(n) asm volatile("s_waitcnt lgkmcnt(" #n ")" ::: "memory")
#define PG8_BAR __builtin_amdgcn_s_barrier()
#define PG8_SCHED __builtin_amdgcn_sched_barrier(0)
    Unit cur, nxt; int ui = 0;
    if (!S.next(0, cur)) return;
    f32x4 acc[2][2][4][2];
#pragma unroll
    for (int a = 0; a < 2; ++a)
#pragma unroll
        for (int b = 0; b < 2; ++b)
#pragma unroll
            for (int m = 0; m < 4; ++m)
#pragma unroll
                for (int n = 0; n < 2; ++n) acc[a][b][m][n] = (f32x4){0.f, 0.f, 0.f, 0.f};
    bf16x8 At[4][2], B0[2][2], B1[2][2];
    const char* cA = (const char*)g.A + (size_t)cur.pm * tstep; const char* cB = (const char*)g.Bt + (size_t)cur.pn * tstep;
    S.a_ready(cur);
    if constexpr (SP2) {
        PG8_STAGE(PG8_SB(0, 0), cB, voffB); PG8_STAGE(PG8_SB(0, 1), cB + hstep, voffB); PG8_STAGE(PG8_SA(0, 0), cA, voffA); PG8_STAGE(PG8_SA(0, 1), cA + hstep, voffA);
        if (wr == 1) PG8_BAR;
        PG8_WAIT_V(2); PG8_BAR;
        PG8_STAGE(PG8_SB(1, 0), cB + kstep, voffB); PG8_STAGE(PG8_SA(1, 0), cA + kstep, voffA); PG8_STAGE(PG8_SB(1, 1), cB + hstep + kstep, voffB);
        PG8_WAIT_V(6); PG8_BAR;
    } else {
        PG8_STAGE(PG8_SB(0, 0), cB, voffB); PG8_STAGE(PG8_SA(0, 0), cA, voffA); PG8_STAGE(PG8_SB(0, 1), cB + hstep, voffB); PG8_STAGE(PG8_SA(0, 1), cA + hstep, voffA);
        if (wr == 1) PG8_BAR;
        PG8_WAIT_V(4); PG8_BAR;
        PG8_STAGE(PG8_SB(1, 0), cB + kstep, voffB); PG8_STAGE(PG8_SA(1, 0), cA + kstep, voffA); PG8_STAGE(PG8_SB(1, 1), cB + hstep + kstep, voffB);
        PG8_WAIT_V(6); PG8_BAR;
    }
    for (;;) {
        const bool has_next = S.next(ui + 1, nxt);
        const char* nA = has_next ? (const char*)g.A + (size_t)nxt.pm * tstep : cA; const char* nB = has_next ? (const char*)g.Bt + (size_t)nxt.pn * tstep : cB;
        for (int t = 0; t < nt; t += 2) {
            const bool last = (t == nt - 2);
            const char* a1 = cA + (size_t)(t + 1) * kstep;
            const char* a2 = last ? nA : cA + (size_t)(t + 2) * kstep; const char* b2 = last ? nB : cB + (size_t)(t + 2) * kstep;
            const char* a3 = a2 + kstep; const char* b3 = b2 + kstep;
            if (last && has_next) S.a_ready(nxt);
            if constexpr (SP2) {
            PG8_LDB(B0, 0, 0); PG8_LDB(B1, 0, 1); PG8_SCHED; PG8_LDA(At, 0, 0); PG8_STAGE(PG8_SA(1, 1), a1 + hstep, voffA);
            PG8_WAIT_V(8); PG8_WAIT_L(0); PG8_BAR; PG8_MMA(0, 0, At, B0); PG8_MMA(0, 1, At, B1); PG8_BAR; PG8_SCHED;
            PG8_LDA(At, 0, 1); PG8_STAGE(PG8_SB(0, 0), b2, voffB); PG8_STAGE(PG8_SB(0, 1), b2 + hstep, voffB); PG8_STAGE(PG8_SA(0, 0), a2, voffA);
            PG8_WAIT_V(8); PG8_WAIT_L(0); PG8_BAR; PG8_MMA(1, 0, At, B0); PG8_MMA(1, 1, At, B1); PG8_BAR; PG8_SCHED;
            PG8_LDB(B0, 1, 0); PG8_LDB(B1, 1, 1); PG8_SCHED; PG8_LDA(At, 1, 0); PG8_STAGE(PG8_SA(0, 1), a2 + hstep, voffA);
            PG8_WAIT_V(8); PG8_WAIT_L(0); PG8_BAR; PG8_MMA(0, 0, At, B0); PG8_MMA(0, 1, At, B1); PG8_BAR; PG8_SCHED;
            PG8_LDA(At, 1, 1); PG8_STAGE(PG8_SB(1, 0), b3, voffB); PG8_STAGE(PG8_SB(1, 1), b3 + hstep, voffB); PG8_STAGE(PG8_SA(1, 0), a3, voffA);
            PG8_WAIT_V(8); PG8_WAIT_L(0); PG8_BAR; PG8_MMA(1, 0, At, B0); PG8_MMA(1, 1, At, B1); PG8_BAR; PG8_SCHED;
            } else {
            PG8_LDB(B0, 0, 0); PG8_SCHED; PG8_LDA(At, 0, 0); PG8_STAGE(PG8_SA(1, 1), a1 + hstep, voffA);
            PG8_WAIT_L(8); PG8_BAR; PG8_WAIT_L(0); PG8_MMA(0, 0, At, B0); PG8_BAR; PG8_SCHED;
            PG8_LDB(B1, 0, 1); PG8_STAGE(PG8_SB(0, 0), b2, voffB);
            PG8_BAR; PG8_WAIT_L(0); PG8_MMA(0, 1, At, B1); PG8_BAR;
            PG8_LDA(At, 0, 1); PG8_STAGE(PG8_SA(0, 0), a2, voffA);
            PG8_BAR; PG8_WAIT_L(0); PG8_MMA(1, 0, At, B0); PG8_BAR; PG8_SCHED;
            PG8_STAGE(PG8_SB(0, 1), b2 + hstep, voffB);
            PG8_WAIT_V(6); PG8_BAR; PG8_MMA(1, 1, At, B1); PG8_BAR;
            PG8_LDB(B0, 1, 0); PG8_SCHED; PG8_LDA(At, 1, 0); PG8_STAGE(PG8_SA(0, 1), a2 + hstep, voffA);
            PG8_WAIT_L(8); PG8_BAR; PG8_WAIT_L(0); PG8_MMA(0, 0, At, B0); PG8_BAR; PG8_SCHED;
            PG8_LDB(B1, 1, 1); PG8_STAGE(PG8_SB(1, 0), b3, voffB);
            PG8_BAR; PG8_WAIT_L(0); PG8_MMA(0, 1, At, B1); PG8_BAR;
            PG8_LDA(At, 1, 1); PG8_STAGE(PG8_SA(1, 0), a3, voffA);
            PG8_BAR; PG8_WAIT_L(0); PG8_MMA(1, 0, At, B0); PG8_BAR; PG8_SCHED;
            PG8_STAGE(PG8_SB(1, 1), b3 + hstep, voffB);
            PG8_WAIT_V(6); PG8_BAR; PG8_MMA(1, 1, At, B1); PG8_BAR;
            }
        }
        if constexpr (ALIGN_EPI) { if (wr == 0) PG8_BAR; }
        if constexpr (!Epi::AFTER_DRAIN) { E(acc, cur, wr, wc, fr, fq); S.done(cur); }
        if (!has_next) break;
#pragma unroll
        for (int a = 0; a < 2; ++a)
#pragma unroll
            for (int b = 0; b < 2; ++b)
#pragma unroll
                for (int m = 0; m < 4; ++m)
#pragma unroll
                    for (int n = 0; n < 2; ++n) acc[a][b][m][n] = (f32x4){0.f, 0.f, 0.f, 0.f};
        cur = nxt; cA = nA; cB = nB; ++ui;
        if constexpr (ALIGN_EPI) { if (wr == 1) PG8_BAR; }
    }
    PG8_WAIT_V(0);
    if constexpr (!ALIGN_EPI) { if (wr == 0) PG8_BAR; }
    PG8_BAR;
    if constexpr (Epi::AFTER_DRAIN) { E.fused(acc, cur, wr, wc, fr, fq, lds, wid, lane); S.done(cur); }
#undef PG8_SA
#undef PG8_SB
#undef PG8_STAGE
#undef PG8_LDA
#undef PG8_LDB
#undef PG8_MMA
#undef PG8_WAIT_V
#undef PG8_WAIT_L
#undef PG8_BAR
#undef PG8_SCHED
}
}
#include <hip/hip_bf16.h>
#include <cmath>
namespace attn_body {
using bf16=__hip_bfloat16;
using bf16x8=__attribute__((ext_vector_type(8)))short;
using s16x4=__attribute__((ext_vector_type(4)))short;
using f32x16=__attribute__((ext_vector_type(16)))float;
using u32x4=__attribute__((ext_vector_type(4)))unsigned;
constexpr int SEQ=8192,D=64,PQ=512,PKV=128;
constexpr int NW=8,QBLK=32,QB=QBLK*NW,KVBLK=64,NQB=SEQ/QB;
constexpr int ATTN_UNIT_ROWS=QB;
__device__ __forceinline__ int crow(int r,int hi){return (r&3)+8*(r>>2)+4*hi;}
#define SBAR() __builtin_amdgcn_sched_barrier(0)
__device__ __forceinline__ void cmask(f32x16&p0,f32x16&p1,int jb,int qrel,int hi){
  const float NEG=-INFINITY; int kb=64*jb+4*hi;
  #pragma unroll
  for(int r=0;r<16;++r){int kv=kb+(r&3)+8*(r>>2); if(kv>qrel)p0[r]=NEG; if(kv+32>qrel)p1[r]=NEG;}
}

constexpr int NSLOT=3, SLOTB=8192;
constexpr int LDS_K=0, LDS_V=NSLOT*SLOTB, LDS_WS=2*NSLOT*SLOTB, LDS_OST=LDS_WS+NW*64*4, LDS_BYTES=LDS_OST+NW*4096;
constexpr float C2=0.125f*1.4426950408889634f;
__device__ __forceinline__ void glds16(const void*gsrc,unsigned lds_dst){unsigned keep;
  asm volatile("s_mov_b32 %0, m0\n\ts_mov_b32 m0, %2\n\ts_nop 0\n\tglobal_load_lds_dwordx4 %1, off\n\ts_mov_b32 m0, %0":"=&s"(keep):"v"(gsrc),"s"(lds_dst):"memory");}
__device__ __forceinline__ float max3f(float a,float b,float c){float r;asm("v_max3_f32 %0, %1, %2, %3":"=v"(r):"v"(a),"v"(b),"v"(c));return r;}
__device__ __forceinline__ float max2f(float a,float b){float r;asm("v_max_f32_e32 %0, %1, %2":"=v"(r):"v"(a),"v"(b));return r;}
__device__ __forceinline__ float fadd_s(float a,float b){float r;asm("v_add_f32_e32 %0, %1, %2":"=v"(r):"v"(a),"v"(b));return r;}
__device__ __forceinline__ float fsub_s(float a,float b){float r;asm("v_sub_f32_e32 %0, %1, %2":"=v"(r):"v"(a),"v"(b));return r;}
typedef float f32x2_t __attribute__((ext_vector_type(2))); typedef __bf16 bf16x2_t __attribute__((ext_vector_type(2)));
__device__ __forceinline__ unsigned cvtpk_s(float lo,float hi){f32x2_t v={lo,hi};bf16x2_t b=__builtin_convertvector(v,bf16x2_t);return __builtin_bit_cast(unsigned,b);}
#define WAIT_BAR(N) asm volatile("s_waitcnt vmcnt(" #N ") lgkmcnt(0)\n\ts_barrier":::"memory")

__device__ __forceinline__ void qkt(f32x16&p0,f32x16&p1,const char*Kslot,const bf16x8*qr,const f32x16&negm,int r32,int hi){
  const char*kb=Kslot+hi*1024+r32*16;
  #pragma unroll
  for(int d0=0;d0<4;++d0){
    const bf16x8 b0=*reinterpret_cast<const bf16x8*>(kb+d0*2048);
    const bf16x8 b1=*reinterpret_cast<const bf16x8*>(kb+d0*2048+512);
    if(d0==0){p0=__builtin_amdgcn_mfma_f32_32x32x16_bf16(b0,qr[0],negm,0,0,0);p1=__builtin_amdgcn_mfma_f32_32x32x16_bf16(b1,qr[0],negm,0,0,0);}
    else{p0=__builtin_amdgcn_mfma_f32_32x32x16_bf16(b0,qr[d0],p0,0,0,0);p1=__builtin_amdgcn_mfma_f32_32x32x16_bf16(b1,qr[d0],p1,0,0,0);}}
}
typedef __attribute__((address_space(3))) const char* lds_cptr;
typedef short v4i16_t __attribute__((ext_vector_type(4)));
__device__ __forceinline__ void kload8(bf16x8*kf,lds_cptr kp){
  kf[0]=*(const __attribute__((address_space(3))) bf16x8*)(kp);      kf[1]=*(const __attribute__((address_space(3))) bf16x8*)(kp+512);
  kf[2]=*(const __attribute__((address_space(3))) bf16x8*)(kp+2048); kf[3]=*(const __attribute__((address_space(3))) bf16x8*)(kp+2560);
  kf[4]=*(const __attribute__((address_space(3))) bf16x8*)(kp+4096); kf[5]=*(const __attribute__((address_space(3))) bf16x8*)(kp+4608);
  kf[6]=*(const __attribute__((address_space(3))) bf16x8*)(kp+6144); kf[7]=*(const __attribute__((address_space(3))) bf16x8*)(kp+6656);
}
__device__ __forceinline__ void kload2(bf16x8*kf,lds_cptr kp,int j){ kf[2*j]=*(const __attribute__((address_space(3))) bf16x8*)(kp+j*2048); kf[2*j+1]=*(const __attribute__((address_space(3))) bf16x8*)(kp+j*2048+512); }
__device__ __forceinline__ s16x4 vtr(lds_cptr p){ return __builtin_bit_cast(s16x4,__builtin_amdgcn_ds_read_tr16_b64_v4i16((__attribute__((address_space(3))) v4i16_t*)p)); }
__device__ __forceinline__ float rowmax(const f32x16&p0,const f32x16&p1){
  float a=max3f(p0[0],p0[1],p1[0]),b=max3f(p0[2],p0[3],p1[1]);a=max3f(a,p1[2],p1[3]);
  #pragma unroll
  for(int r=4;r<16;r+=4){a=max3f(a,p0[r],p0[r+1]);b=max3f(b,p0[r+2],p0[r+3]);a=max3f(a,p1[r],p1[r+1]);b=max3f(b,p1[r+2],p1[r+3]);}
  const float m=max2f(a,b);
  auto rr=__builtin_amdgcn_permlane32_swap(__float_as_uint(m),__float_as_uint(m),false,false);
  return max2f(__uint_as_float(rr[0]),__uint_as_float(rr[1]));
}
__device__ __forceinline__ void pv(f32x16*o,int vb,bf16x8 pa0,bf16x8 pa1,bf16x8 pa2,bf16x8 pa3){
  #pragma unroll
  for(int d0=0;d0<2;++d0){s16x4 lo[4],hi[4];
    #pragma unroll
    for(int ks=0;ks<4;++ks){
      asm volatile("ds_read_b64_tr_b16 %0,%1 offset:%c2":"=&v"(lo[ks]):"v"(vb),"i"(d0*4096+ks*1024):"memory");
      asm volatile("ds_read_b64_tr_b16 %0,%1 offset:%c2":"=&v"(hi[ks]):"v"(vb),"i"(d0*4096+ks*1024+512):"memory");}
    asm volatile("s_waitcnt lgkmcnt(0)":::"memory");SBAR();
    #define PK(k) (bf16x8){lo[k][0],lo[k][1],lo[k][2],lo[k][3],hi[k][0],hi[k][1],hi[k][2],hi[k][3]}
    o[d0]=__builtin_amdgcn_mfma_f32_32x32x16_bf16(pa0,PK(0),o[d0],0,0,0);
    o[d0]=__builtin_amdgcn_mfma_f32_32x32x16_bf16(pa1,PK(1),o[d0],0,0,0);
    o[d0]=__builtin_amdgcn_mfma_f32_32x32x16_bf16(pa2,PK(2),o[d0],0,0,0);
    o[d0]=__builtin_amdgcn_mfma_f32_32x32x16_bf16(pa3,PK(3),o[d0],0,0,0);
    #undef PK
  }
}

#ifndef ATTN_STORE16
#define ATTN_STORE16(p,v) (*(u32x4*)(p)=(v))
#endif
template<int THRL> __device__ __forceinline__ void attn_unit(int b,int h,int kvh,int qb,const bf16*Q,const bf16*__restrict__ K,const bf16*__restrict__ V,bf16*O,char*shm){
  int tid_raw=threadIdx.x; asm volatile("":"+v"(tid_raw));
  const int tid=tid_raw,lane=tid&63,r32=lane&31,hi=lane>>5; const int wid=__builtin_amdgcn_readfirstlane(tid>>6);
  const long rowbase=(long)b*SEQ; const int q0=qb*QB;
  const bf16*Qw=Q+(rowbase+q0+wid*QBLK)*PQ+h*D;
  const bf16*Kh=K+rowbase*PKV+kvh*D,*Vh=V+rowbase*PKV+kvh*D;
  const unsigned lds0=(unsigned)(uintptr_t)shm;
  float*wsf=(float*)(shm+LDS_WS)+wid*64;
  const bf16*ksrc=Kh+(long)lane*PKV+wid*8;
  const bf16*vsrc=Vh+(long)(16*(wid&3)+(lane>>2))*PKV+(wid>>2)*32+(lane&3)*8;
  const unsigned kdst=lds0+LDS_K+wid*1024, vdst=lds0+LDS_V+wid*1024;
  #define DMA_K(t,slot) glds16(ksrc+(long)(t)*KVBLK*PKV,(unsigned)__builtin_amdgcn_readfirstlane(kdst+(slot)))
  #define DMA_V(t,slot) glds16(vsrc+(long)(t)*KVBLK*PKV,(unsigned)__builtin_amdgcn_readfirstlane(vdst+(slot)))
  const int vb0=(int)(lds0+LDS_V)+((lane>>4)&1)*32+(lane&3)*8+(4*hi+((lane&15)>>2))*64;
  const char*Kbase=shm+LDS_K; bf16x8 kf[8];
  const lds_cptr shm3=(lds_cptr)shm; const lds_cptr kp0=shm3+LDS_K+hi*1024+r32*16; const lds_cptr vp0=shm3+LDS_V+((lane>>4)&1)*32+(lane&3)*8+(4*hi+((lane&15)>>2))*64;
  const int NT=SEQ/KVBLK;
  DMA_K(0,0);DMA_V(0,0);DMA_K(1,SLOTB);
  bf16x8 qr[4];
  #pragma unroll
  for(int d0=0;d0<4;++d0)qr[d0]=*reinterpret_cast<const bf16x8*>(&Qw[(long)r32*PQ+d0*16+hi*8]);
  float mhat=0.f,l_reg=0.f;f32x16 o[2];o[0]=f32x16{};o[1]=f32x16{};f32x16 negm=f32x16{};asm volatile("":"+v"(negm));
  const int qrel=wid*QBLK+r32;
  #define CMASK(P0,P1,t) do{}while(0)
  bool resc=false;
  #define START(P0,P1) do{ const float rm=rowmax(P0,P1); resc=false; \
    { const float dl=rm; mhat=fadd_s(mhat,dl); \
      _Pragma("unroll") for(int r=0;r<16;++r){P0[r]=fsub_s(P0[r],dl);P1[r]=fsub_s(P1[r],dl);} \
      _Pragma("unroll") for(int r=0;r<16;++r)negm[r]=-mhat; asm volatile("":"+v"(negm)); } \
    _Pragma("unroll") for(int r=0;r<16;++r)P0[r]=__builtin_amdgcn_exp2f(P0[r]); }while(0)
  #define RESC() do{ if(resc){ asm volatile("s_waitcnt lgkmcnt(0)":::"memory"); \
      _Pragma("unroll") for(int d_=0;d_<2;++d_) _Pragma("unroll") for(int r=0;r<16;++r)o[d_][r]*=wsf[crow(r,hi)]; } }while(0)
  f32x16 pA0,pA1,pB0,pB1;
  int sl_prev=0,sl_cur=0,sl_next=SLOTB;
  #define ROT() do{sl_prev=sl_cur;sl_cur=sl_next;sl_next=(sl_next==(NSLOT-1)*SLOTB)?0:sl_next+SLOTB;}while(0)
  DMA_K(2,2*SLOTB);
  WAIT_BAR(3);
  qkt(pA0,pA1,Kbase,qr,negm,r32,hi);asm volatile("s_nop 15\n\ts_nop 7":"+v"(pA0),"+v"(pA1));CMASK(pA0,pA1,0);
  START(pA0,pA1);
  _Pragma("unroll") for(int r=0;r<16;++r)pA1[r]=__builtin_amdgcn_exp2f(pA1[r]);
  WAIT_BAR(0);
  DMA_K(3,0);DMA_V(1,SLOTB);
  ROT();
  kload8(kf,kp0+sl_cur);
  WAIT_BAR(2);
  s16x4 vlo[8],vhi[8]; u32x4 pw0,pw1,pw2,pw3;
  #define PKW(P,B) cvtpk_s(P[B],P[B+1])
  #define PAF(k) __builtin_bit_cast(bf16x8,pw##k)
  #define VFR(i) (bf16x8){vlo[i][0],vlo[i][1],vlo[i][2],vlo[i][3],vhi[i][0],vhi[i][1],vhi[i][2],vhi[i][3]}
  #define PIN(x) asm volatile("":"+v"(x))
  #define MX3(a,b,c) __builtin_fmaxf(__builtin_fmaxf((a),(b)),(c))
  #define GAPA(MF,A0,A1,A2,A3,W0,W1,PW) do{ MF; sacc+=A0; sacc+=A1; sacc+=A2; sacc+=A3; PIN(sacc); W0; W1; PIN(PW); SBAR(); }while(0)
  #define EX(v) __builtin_amdgcn_exp2f(v)
  #define GAPB(MF,X,B) do{ MF; X[B]=EX(X[B]); X[B+1]=EX(X[B+1]); X[B+2]=EX(X[B+2]); X[B+3]=EX(X[B+3]); PIN(X); SBAR(); }while(0)
  #define VRD(i) do{ vlo[i]=vtr(vp_+(((i)>>2)*4096+((i)&3)*1024)); vhi[i]=vtr(vp_+(((i)>>2)*4096+((i)&3)*1024+512)); }while(0)
  #define KRD(G,j) do{ if(G){ kload2(kf,kp0+sl_next,j); SBAR(); } }while(0)
  #define STEP(C0,C1,P0,P1,t,GK,GV,GL) do{ SBAR(); \
    const lds_cptr vp_=vp0+sl_prev; \
    VRD(0); SBAR(); float sacc=(P0[0]+P0[1]); \
    GAPA(C0=__builtin_amdgcn_mfma_f32_32x32x16_bf16(kf[0],qr[0],negm,0,0,0), P0[2],P0[3],P0[4],P0[5],     pw0[0]=PKW(P0,0), pw0[1]=PKW(P0,2), pw0); \
    VRD(4); SBAR(); GAPA(C1=__builtin_amdgcn_mfma_f32_32x32x16_bf16(kf[1],qr[0],negm,0,0,0), P0[6],P0[7],P0[8],P0[9],     pw0[2]=PKW(P0,4), pw0[3]=PKW(P0,6), pw0); \
    VRD(1); SBAR(); GAPA(C0=__builtin_amdgcn_mfma_f32_32x32x16_bf16(kf[2],qr[1],C0,0,0,0),   P0[10],P0[11],P0[12],P0[13], pw1[0]=PKW(P0,8), pw1[1]=PKW(P0,10), pw1); \
    VRD(5); SBAR(); GAPA(C1=__builtin_amdgcn_mfma_f32_32x32x16_bf16(kf[3],qr[1],C1,0,0,0),   P0[14],P0[15],P1[0],P1[1],   pw1[2]=PKW(P0,12),pw1[3]=PKW(P0,14), pw1); \
    VRD(2); SBAR(); GAPA(C0=__builtin_amdgcn_mfma_f32_32x32x16_bf16(kf[4],qr[2],C0,0,0,0),   P1[2],P1[3],P1[4],P1[5],     pw2[0]=PKW(P1,0), pw2[1]=PKW(P1,2), pw2); \
    VRD(6); SBAR(); GAPA(C1=__builtin_amdgcn_mfma_f32_32x32x16_bf16(kf[5],qr[2],C1,0,0,0),   P1[6],P1[7],P1[8],P1[9],     pw2[2]=PKW(P1,4), pw2[3]=PKW(P1,6), pw2); \
    VRD(3); SBAR(); GAPA(C0=__builtin_amdgcn_mfma_f32_32x32x16_bf16(kf[6],qr[3],C0,0,0,0),   P1[10],P1[11],P1[12],P1[13], pw3[0]=PKW(P1,8), pw3[1]=PKW(P1,10), pw3); \
    VRD(7); SBAR(); GAPA(C1=__builtin_amdgcn_mfma_f32_32x32x16_bf16(kf[7],qr[3],C1,0,0,0),   P1[14],P1[15],0.f,0.f,       pw3[2]=PKW(P1,12),pw3[3]=PKW(P1,14), pw3); \
    l_reg+=sacc; \
    if(GK){DMA_K((t)+3,sl_cur);} if(GV){DMA_V((t)+1,sl_next);} \
    CMASK(C0,C1,t); \
    { float a=MX3(C0[0],C0[1],C1[0]),b=MX3(C0[2],C0[3],C1[1]); a=MX3(a,C1[2],C1[3]); \
      _Pragma("unroll") for(int r=4;r<16;r+=4){a=MX3(a,C0[r],C0[r+1]);b=MX3(b,C0[r+2],C0[r+3]);a=MX3(a,C1[r],C1[r+1]);b=MX3(b,C1[r+2],C1[r+3]);} \
      float rm=__builtin_fmaxf(a,b); { auto rr=__builtin_amdgcn_permlane32_swap(__float_as_uint(rm),__float_as_uint(rm),false,false); rm=__builtin_fmaxf(__uint_as_float(rr[0]),__uint_as_float(rr[1])); } \
      resc=false; \
      if(__builtin_expect(__any(rm>(float)THRL),0)){ const float dl=__builtin_fmaxf(rm,0.f); mhat+=dl; \
        _Pragma("unroll") for(int r=0;r<16;++r){C0[r]-=dl;C1[r]-=dl;} \
        _Pragma("unroll") for(int r=0;r<16;++r)negm[r]=-mhat; asm volatile("":"+v"(negm)); \
        const float f=__builtin_amdgcn_exp2f(-dl); l_reg*=f; if(hi==0)wsf[r32]=f; resc=true; } } \
    SBAR(); \
    GAPB(o[0]=__builtin_amdgcn_mfma_f32_32x32x16_bf16(PAF(0),VFR(0),o[0],0,0,0), C0,0); \
    GAPB(o[1]=__builtin_amdgcn_mfma_f32_32x32x16_bf16(PAF(0),VFR(4),o[1],0,0,0), C0,4); \
    KRD(GL,0); GAPB(o[0]=__builtin_amdgcn_mfma_f32_32x32x16_bf16(PAF(1),VFR(1),o[0],0,0,0), C0,8); \
    KRD(GL,1); GAPB(o[1]=__builtin_amdgcn_mfma_f32_32x32x16_bf16(PAF(1),VFR(5),o[1],0,0,0), C0,12); \
    KRD(GL,2); GAPB(o[0]=__builtin_amdgcn_mfma_f32_32x32x16_bf16(PAF(2),VFR(2),o[0],0,0,0), C1,0); \
    KRD(GL,3); GAPB(o[1]=__builtin_amdgcn_mfma_f32_32x32x16_bf16(PAF(2),VFR(6),o[1],0,0,0), C1,4); \
    GAPB(o[0]=__builtin_amdgcn_mfma_f32_32x32x16_bf16(PAF(3),VFR(3),o[0],0,0,0), C1,8); \
    GAPB(o[1]=__builtin_amdgcn_mfma_f32_32x32x16_bf16(PAF(3),VFR(7),o[1],0,0,0), C1,12); \
    }while(0)
  int t=1;
  #undef CMASK
  #define CMASK(P0,P1,t) do{}while(0)
  for(;t+5<NT;t+=2){
    STEP(pB0,pB1,pA0,pA1,t,true,true,true);     WAIT_BAR(2); RESC(); ROT();
    STEP(pA0,pA1,pB0,pB1,t+1,true,true,true);   WAIT_BAR(2); RESC(); ROT();
  }
  #undef CMASK
  #define CMASK(P0,P1,t) do{}while(0)
  #define ENDW(tt) do{ if((tt)+3<NT){WAIT_BAR(2);} else if((tt)+2<NT){WAIT_BAR(1);} else {WAIT_BAR(0);} }while(0)
  for(;t+1<NT;t+=2){
    STEP(pB0,pB1,pA0,pA1,t,(t+3<NT),(t+1<NT),(t+1<NT));       ENDW(t);   RESC(); ROT();
    STEP(pA0,pA1,pB0,pB1,t+1,(t+4<NT),(t+2<NT),(t+2<NT));     ENDW(t+1); RESC(); ROT();
  }
  STEP(pB0,pB1,pA0,pA1,NT-1,false,false,false); RESC();
  { float sacc=pB0[0]+pB0[1]; _Pragma("unroll") for(int r=2;r<16;++r)sacc+=pB0[r]; _Pragma("unroll") for(int r=0;r<16;++r)sacc+=pB1[r]; l_reg+=sacc;
    pw0=(u32x4){PKW(pB0,0),PKW(pB0,2),PKW(pB0,4),PKW(pB0,6)};pw1=(u32x4){PKW(pB0,8),PKW(pB0,10),PKW(pB0,12),PKW(pB0,14)};pw2=(u32x4){PKW(pB1,0),PKW(pB1,2),PKW(pB1,4),PKW(pB1,6)};pw3=(u32x4){PKW(pB1,8),PKW(pB1,10),PKW(pB1,12),PKW(pB1,14)};
    SBAR(); pv(o,vb0+sl_cur,PAF(0),PAF(1),PAF(2),PAF(3)); }
  #undef PKW
  #undef PAF
  #undef VFR
  #undef PIN
  #undef MX3
  #undef GAPA
  #undef GAPB
  #undef EX
  #undef VRD
  #undef KRD
  #undef STEP
  #undef ENDW
  {auto rr=__builtin_amdgcn_permlane32_swap(__float_as_uint(l_reg),__float_as_uint(l_reg),false,false);l_reg=__uint_as_float(rr[0])+__uint_as_float(rr[1]);}
  if(hi==0)wsf[32+r32]=l_reg;asm volatile("s_waitcnt lgkmcnt(0)":::"memory");
  float rli[16];
  #pragma unroll
  for(int r=0;r<16;++r)rli[r]=__builtin_amdgcn_rcpf(wsf[32+crow(r,hi)]);
  bf16*Ow=O+(rowbase+q0+wid*QBLK)*PQ+h*D;
  { bf16*stg=(bf16*)(shm+LDS_OST)+wid*2048;
    #pragma unroll
    for(int r=0;r<16;++r){const int orow=crow(r,hi);
      #pragma unroll
      for(int d0=0;d0<2;++d0)stg[orow*64+d0*32+r32]=__float2bfloat16(o[d0][r]*rli[r]);}
    asm volatile("s_waitcnt lgkmcnt(0)":::"memory");
    #pragma unroll
    for(int i=0;i<4;++i){const int row=i*8+(lane>>3),ch=lane&7; const u32x4 v=*(const u32x4*)(stg+row*64+ch*8); ATTN_STORE16(Ow+(long)row*PQ+ch*8,v);} }
  asm volatile("s_waitcnt lgkmcnt(0)\n\ts_barrier":::"memory");
  #undef DMA_K
  #undef DMA_V
  #undef CMASK
  #undef START
  #undef RESC
  #undef ROT
}
constexpr int ATTN_LDS_BYTES=LDS_BYTES;
#undef SBAR
#undef WAIT_BAR
}
#define LAS __attribute__((address_space(3)))
constexpr int SEQ = 8192, BATCH = 4, MTOK = BATCH * SEQ, DMODEL = 1024, DEPTH = 4, DFF = 2816, INW = 6656, GATEW = 3072;
constexpr float RMS_EPS = 1e-6f;
constexpr float QSCALE = 0.125f * 1.4426950408889634f;
constexpr int NWAVES = 8;
typedef pg8::bf16_t bf16_t;
typedef pg8::f32x4 f32x4;
typedef pg8::bf16x8 bf16x8;
typedef unsigned u32x2 __attribute__((ext_vector_type(2)));
typedef unsigned u32x4v __attribute__((ext_vector_type(4)));

constexpr size_t W_IN = 0, W_A = W_IN + (size_t)INW * 1024, W_B = W_A + 1024 * 512, W_C = W_B + 1024 * 256, W_O3 = W_C + 1024 * 512,
                 W_GU = W_O3 + (size_t)1024 * 3072, W_D = W_GU + (size_t)2 * DFF * 1024, W_LAYER = W_D + (size_t)1024 * DFF;
static_assert(W_LAYER * 2 == 38u * 1048576u, "weight block is 38 MiB");
constexpr size_t MiB = 1u << 20;
constexpr size_t WS_W = 1 * MiB, WS_H = 153 * MiB, WS_QA = 217 * MiB, WS_BIG = 249 * MiB, WS_OB = 441 * MiB, WS_PC = 457 * MiB, WS_END = 489 * MiB;
constexpr size_t BIG_KA = 0, BIG_VA = 8 * MiB, BIG_QB = 16 * MiB, BIG_KB = 64 * MiB, BIG_VB = 112 * MiB, BIG_UC = 160 * MiB;
constexpr int LDS_BYTES = 147456;

__device__ __forceinline__ float bf2f(unsigned short h) { return __builtin_bit_cast(float, (unsigned)h << 16); }
__device__ __forceinline__ float bflo(unsigned w) { return __builtin_bit_cast(float, w << 16); }
__device__ __forceinline__ float bfhi(unsigned w) { return __builtin_bit_cast(float, w & 0xffff0000u); }
__device__ __forceinline__ unsigned pkbf(float lo, float hi) { return pg8::cvt_pk_bf16(lo, hi); }
__device__ __forceinline__ int finv(int f) { return (f & ~255) | (((f >> 5) & 1) << 7) | (((f >> 6) & 3) << 5) | (f & 31); }
__device__ __forceinline__ void sincos_rad(float ang, float& s, float& c) { float r = __builtin_amdgcn_fractf(ang * 0.15915494309189535f); s = __builtin_amdgcn_sinf(r); c = __builtin_amdgcn_cosf(r); }
__device__ __forceinline__ float sigmoidf_(float v) { return __builtin_amdgcn_rcpf(1.0f + __builtin_amdgcn_exp2f(-1.4426950408889634f * v)); }

namespace pg8 {
struct EpiInProj1 {
    static constexpr bool PERM = false, AFTER_DRAIN = false;
    bf16_t *QA, *KA, *VA, *QB, *KB, *VB, *UC; const float *qn_a, *kn_a, *qn_b, *kn_b;
    __device__ __forceinline__ void operator()(const f32x4 (&acc)[2][2][4][2], const Unit& u, int wr, int wc, int fr, int fq) const {
        const int f0 = u.pn * BM + wc * 64;
        bf16_t* dst; int ld, mode; const float* gain = nullptr; float osc = 1.f;
        if (f0 < 512) { dst = QA + f0; ld = 512; mode = 1; gain = qn_a; osc = QSCALE; }
        else if (f0 < 640) { dst = KA + (f0 - 512); ld = 128; mode = 1; gain = kn_a; }
        else if (f0 < 768) { dst = VA + (f0 - 640); ld = 128; mode = 0; }
        else if (f0 < 1536) { dst = QB + (f0 - 768); ld = 768; mode = 2; gain = qn_b; osc = QSCALE; }
        else if (f0 < 2304) { dst = KB + (f0 - 1536); ld = 768; mode = 2; gain = kn_b; }
        else if (f0 < 3072) { dst = VB + (f0 - 2304); ld = 768; mode = 0; }
        else { dst = UC + (f0 - 3072); ld = 512; mode = 0; }
        const int row0 = u.pm * BM + wr * 64 + fr;
        if (mode == 0) {
#pragma unroll
            for (int ai = 0; ai < 2; ++ai)
#pragma unroll
                for (int m = 0; m < 4; ++m) { bf16_t* rp = dst + (size_t)(row0 + ai * HALF + m * 16) * ld + 4 * fq;
#pragma unroll
                    for (int bj = 0; bj < 2; ++bj)
#pragma unroll
                        for (int n = 0; n < 2; ++n) { const f32x4 v = acc[ai][bj][m][n]; u32x2 w; w.x = cvt_pk_bf16(v[0], v[1]); w.y = cvt_pk_bf16(v[2], v[3]); *(u32x2*)(rp + 32 * bj + 16 * n) = w; } }
            return;
        }
        f32x4 g[2][2];
#pragma unroll
        for (int bj = 0; bj < 2; ++bj)
#pragma unroll
            for (int n = 0; n < 2; ++n) g[bj][n] = *(const f32x4*)(gain + 32 * bj + 16 * n + 4 * fq);
        float inv[2][4];
        const float L2T = 13.287712379549449f;
#pragma unroll
        for (int n = 0; n < 2; ++n)
#pragma unroll
            for (int j = 0; j < 4; ++j) inv[n][j] = (mode == 2) ? __builtin_amdgcn_exp2f(-(float)(16 * n + 4 * fq + j) * (L2T / 32.f)) : __builtin_amdgcn_exp2f(-(float)(4 * fq + j) * (L2T / 16.f));
#pragma unroll
        for (int ai = 0; ai < 2; ++ai)
#pragma unroll
            for (int m = 0; m < 4; ++m) {
                const int row = row0 + ai * HALF + m * 16; const int t = row & (SEQ - 1);
                float ss = 0.f;
#pragma unroll
                for (int bj = 0; bj < 2; ++bj)
#pragma unroll
                    for (int n = 0; n < 2; ++n) { const f32x4 v = acc[ai][bj][m][n]; ss += (v[0] * v[0] + v[1] * v[1]) + (v[2] * v[2] + v[3] * v[3]); }
                ss += __shfl_xor(ss, 16); ss += __shfl_xor(ss, 32);
                const float rs = __builtin_amdgcn_rsqf(ss * (1.f / 64.f) + RMS_EPS);
                f32x4 y[2][2], o[2][2];
#pragma unroll
                for (int bj = 0; bj < 2; ++bj)
#pragma unroll
                    for (int n = 0; n < 2; ++n) y[bj][n] = acc[ai][bj][m][n] * rs * g[bj][n];
                if (mode == 2) {
                    const float tf = (float)t;
#pragma unroll
                    for (int n = 0; n < 2; ++n)
#pragma unroll
                        for (int j = 0; j < 4; ++j) { float s, c; sincos_rad(tf * inv[n][j], s, c); const float x1 = y[0][n][j], x2 = y[1][n][j]; o[0][n][j] = x1 * c - x2 * s; o[1][n][j] = x2 * c + x1 * s; }
                } else {
#pragma unroll
                    for (int bj = 0; bj < 2; ++bj) { const float pf = (float)(bj == 0 ? (t >> 6) : (t & 63));
#pragma unroll
                        for (int j = 0; j < 4; ++j) { float s, c; sincos_rad(pf * inv[0][j], s, c); const float x1 = y[bj][0][j], x2 = y[bj][1][j]; o[bj][0][j] = x1 * c - x2 * s; o[bj][1][j] = x2 * c + x1 * s; } }
                }
                bf16_t* rp = dst + (size_t)row * ld + 4 * fq;
#pragma unroll
                for (int bj = 0; bj < 2; ++bj)
#pragma unroll
                    for (int n = 0; n < 2; ++n) { const f32x4 v = o[bj][n] * osc; u32x2 w; w.x = cvt_pk_bf16(v[0], v[1]); w.y = cvt_pk_bf16(v[2], v[3]); *(u32x2*)(rp + 32 * bj + 16 * n) = w; }
            }
    }
};
struct EpiGates {
    static constexpr bool PERM = true, AFTER_DRAIN = false;
    bf16_t* G; const float* bias;
    __device__ __forceinline__ void operator()(const f32x4 (&acc)[2][2][4][2], const Unit& u, int wr, int wc, int fr, int fq) const {
        const int row0 = u.pm * BM + wr * 64 + fr, col0 = u.pn * BM + wc * 64 + 8 * fq;
#pragma unroll
        for (int bj = 0; bj < 2; ++bj) { const int col = col0 + 32 * bj; const f32x4 b0 = *(const f32x4*)(bias + col), b1 = *(const f32x4*)(bias + col + 4);
#pragma unroll
            for (int ai = 0; ai < 2; ++ai)
#pragma unroll
                for (int m = 0; m < 4; ++m) { const f32x4 v0 = acc[ai][bj][m][0] + b0, v1 = acc[ai][bj][m][1] + b1; u32x4 w;
                    w.x = cvt_pk_bf16(sigmoidf_(v0[0]), sigmoidf_(v0[1])); w.y = cvt_pk_bf16(sigmoidf_(v0[2]), sigmoidf_(v0[3])); w.z = cvt_pk_bf16(sigmoidf_(v1[0]), sigmoidf_(v1[1])); w.w = cvt_pk_bf16(sigmoidf_(v1[2]), sigmoidf_(v1[3]));
                    *(u32x4*)(G + (size_t)(row0 + ai * HALF + m * 16) * GATEW + col) = w; } }
    }
};
struct EpiMerge {
    static constexpr bool PERM = true, AFTER_DRAIN = false;
    const bf16_t* G; bf16_t* Mo; int coloff; int first;
    __device__ __forceinline__ void operator()(const f32x4 (&acc)[2][2][4][2], const Unit& u, int wr, int wc, int fr, int fq) const {
        const int row0 = u.pm * BM + wr * 64 + fr, col0 = u.pn * BM + wc * 64 + 8 * fq;
#pragma unroll
        for (int ai = 0; ai < 2; ++ai)
#pragma unroll
            for (int m = 0; m < 4; ++m) { const int row = row0 + ai * HALF + m * 16; const bf16_t* gp = G + (size_t)row * GATEW + coloff + col0; bf16_t* mp = Mo + (size_t)row * DMODEL + col0;
                u32x4 gv[2], mv[2];
#pragma unroll
                for (int bj = 0; bj < 2; ++bj) { gv[bj] = *(const u32x4*)(gp + 32 * bj); mv[bj] = first ? (u32x4){0u, 0u, 0u, 0u} : *(const u32x4*)(mp + 32 * bj); }
#pragma unroll
                for (int bj = 0; bj < 2; ++bj) { const f32x4 v0 = acc[ai][bj][m][0], v1 = acc[ai][bj][m][1]; const u32x4 gg = gv[bj], mm = mv[bj]; u32x4 w;
                    w.x = cvt_pk_bf16(bflo(mm.x) + bflo(gg.x) * v0[0], bfhi(mm.x) + bfhi(gg.x) * v0[1]); w.y = cvt_pk_bf16(bflo(mm.y) + bflo(gg.y) * v0[2], bfhi(mm.y) + bfhi(gg.y) * v0[3]);
                    w.z = cvt_pk_bf16(bflo(mm.z) + bflo(gg.z) * v1[0], bfhi(mm.z) + bfhi(gg.z) * v1[1]); w.w = cvt_pk_bf16(bflo(mm.w) + bflo(gg.w) * v1[2], bfhi(mm.w) + bfhi(gg.w) * v1[3]);
                    *(u32x4*)(mp + 32 * bj) = w; } }
    }
};
struct EpiRes {
    static constexpr bool PERM = true, AFTER_DRAIN = false;
    const float* base; float* out;
    __device__ __forceinline__ void operator()(const f32x4 (&acc)[2][2][4][2], const Unit& u, int wr, int wc, int fr, int fq) const {
        const int row0 = u.pm * BM + wr * 64 + fr, col0 = u.pn * BM + wc * 64 + 8 * fq;
#pragma unroll
        for (int ai = 0; ai < 2; ++ai)
#pragma unroll
            for (int m = 0; m < 4; ++m) { const size_t off = (size_t)(row0 + ai * HALF + m * 16) * DMODEL + col0;
                f32x4 bv[2][2];
#pragma unroll
                for (int bj = 0; bj < 2; ++bj)
#pragma unroll
                    for (int n = 0; n < 2; ++n) bv[bj][n] = *(const f32x4*)(base + off + 32 * bj + 4 * n);
#pragma unroll
                for (int bj = 0; bj < 2; ++bj)
#pragma unroll
                    for (int n = 0; n < 2; ++n) *(f32x4*)(out + off + 32 * bj + 4 * n) = bv[bj][n] + acc[ai][bj][m][n]; }
    }
};
struct EpiFfn1 {
    static constexpr bool PERM = true, AFTER_DRAIN = false;
    bf16_t* ACT;
    __device__ __forceinline__ void operator()(const f32x4 (&acc)[2][2][4][2], const Unit& u, int wr, int wc, int fr, int fq) const {
        const int row0 = u.pm * BM + wr * 64 + fr, col0 = u.pn * HALF + wc * 32 + 8 * fq;
#pragma unroll
        for (int ai = 0; ai < 2; ++ai)
#pragma unroll
            for (int m = 0; m < 4; ++m) { bf16_t* rp = ACT + (size_t)(row0 + ai * HALF + m * 16) * DFF + col0; f32x4 r[2];
#pragma unroll
                for (int n = 0; n < 2; ++n) { const f32x4 gt = acc[ai][0][m][n], up = acc[ai][1][m][n];
#pragma unroll
                    for (int j = 0; j < 4; ++j) r[n][j] = gt[j] * sigmoidf_(gt[j]) * up[j]; }
                u32x4 w; w.x = cvt_pk_bf16(r[0][0], r[0][1]); w.y = cvt_pk_bf16(r[0][2], r[0][3]); w.z = cvt_pk_bf16(r[1][0], r[1][1]); w.w = cvt_pk_bf16(r[1][2], r[1][3]); *(u32x4*)rp = w; }
    }
};
}

namespace attnb {
typedef short s16x4 __attribute__((ext_vector_type(4)));
typedef short v4i16_t __attribute__((ext_vector_type(4)));
constexpr int PB = 768, VROW = 144, WAVE_LDS = 32 * VROW;
__device__ __forceinline__ s16x4 vtr(LAS const char* p) { return __builtin_bit_cast(s16x4, __builtin_amdgcn_ds_read_tr16_b64_v4i16((LAS v4i16_t*)p)); }

template <int DIL>
__device__ __forceinline__ void group(const bf16_t* __restrict__ Qg, const bf16_t* __restrict__ Kg, const bf16_t* __restrict__ Vg, int t0r, LAS char* vl, int lane, float& m_run, float& l_run, f32x4 (&o)[4]) {
    constexpr int STEP = 16 / DIL, NK = 15 * STEP + 129, NC = (NK + 31) / 32, LD = SEQ / DIL;
    const int fr = lane & 15, fq = lane >> 4;
    const int rr = t0r & (DIL - 1), lk0 = t0r / DIL - 64;
    bf16x8 qf[2];
    { const bf16_t* qp = Qg + (size_t)(t0r + 16 * fr) * PB + 8 * fq; qf[0] = *(const bf16x8*)qp; qf[1] = *(const bf16x8*)(qp + 32); }
    bf16x8 kf[3][2][2], vr[3][4];
#define AB_LOAD(c, B) do { \
        _Pragma("unroll") for (int T = 0; T < 2; ++T) { int lk = lk0 + 32 * (c) + 16 * T + fr; lk = lk < 0 ? 0 : (lk > LD - 1 ? LD - 1 : lk); \
            const bf16_t* kp = Kg + (size_t)(lk * DIL + rr) * PB + 8 * fq; kf[B][T][0] = *(const bf16x8*)kp; kf[B][T][1] = *(const bf16x8*)(kp + 32); } \
        _Pragma("unroll") for (int i = 0; i < 4; ++i) { int lk = lk0 + 32 * (c) + (lane >> 3) + 8 * i; lk = lk < 0 ? 0 : (lk > LD - 1 ? LD - 1 : lk); \
            vr[B][i] = *(const bf16x8*)(Vg + (size_t)(lk * DIL + rr) * PB + 8 * (lane & 7)); } } while (0)
    AB_LOAD(0, 0);
    if (NC > 1) AB_LOAD(1, 1);
    LAS char* vw = vl + (lane >> 3) * VROW + (lane & 7) * 16;
    LAS const char* vrd = vl + (4 * fq + (fr >> 2)) * VROW + (fr & 3) * 8;
#define AB_COMPUTE(c, B) do { \
_Pragma("unroll") \
        for (int i = 0; i < 4; ++i) *(LAS bf16x8*)(vw + 8 * i * VROW) = vr[B][i]; \
        f32x4 s[2]; \
_Pragma("unroll") \
        for (int T = 0; T < 2; ++T) { s[T] = __builtin_amdgcn_mfma_f32_16x16x32_bf16(kf[B][T][0], qf[0], (f32x4){0.f, 0.f, 0.f, 0.f}, 0, 0, 0); s[T] = __builtin_amdgcn_mfma_f32_16x16x32_bf16(kf[B][T][1], qf[1], s[T], 0, 0, 0); } \
        bool ok[2][4]; float mx = -1e30f; \
_Pragma("unroll") \
        for (int T = 0; T < 2; ++T) \
_Pragma("unroll") \
            for (int r = 0; r < 4; ++r) { const int k = 32 * (c) + 16 * T + 4 * fq + r, lk = lk0 + k; ok[T][r] = (lk >= 0) && (lk < LD) && (k >= STEP * fr) && (k <= STEP * fr + 128); \
                mx = fmaxf(mx, ok[T][r] ? s[T][r] : -1e30f); } \
        mx = fmaxf(mx, __shfl_xor(mx, 16)); mx = fmaxf(mx, __shfl_xor(mx, 32)); \
        const float m_new = fmaxf(m_run, mx), alpha = __builtin_amdgcn_exp2f(m_run - m_new); \
        float p[2][4], ps = 0.f; \
_Pragma("unroll") \
        for (int T = 0; T < 2; ++T) \
_Pragma("unroll") \
            for (int r = 0; r < 4; ++r) { p[T][r] = ok[T][r] ? __builtin_amdgcn_exp2f(s[T][r] - m_new) : 0.f; ps += p[T][r]; } \
        l_run = l_run * alpha + ps; m_run = m_new; \
_Pragma("unroll") \
        for (int dt = 0; dt < 4; ++dt) o[dt] = o[dt] * alpha; \
        u32x4v pw; pw.x = pkbf(p[0][0], p[0][1]); pw.y = pkbf(p[0][2], p[0][3]); pw.z = pkbf(p[1][0], p[1][1]); pw.w = pkbf(p[1][2], p[1][3]); \
        const bf16x8 pf = __builtin_bit_cast(bf16x8, pw); \
_Pragma("unroll") \
        for (int dt = 0; dt < 4; ++dt) { const s16x4 v0 = vtr(vrd + dt * 32), v1 = vtr(vrd + 16 * VROW + dt * 32); \
            const bf16x8 vf = (bf16x8){v0[0], v0[1], v0[2], v0[3], v1[0], v1[1], v1[2], v1[3]}; \
            o[dt] = __builtin_amdgcn_mfma_f32_16x16x32_bf16(vf, pf, o[dt], 0, 0, 0); } \
    } while (0)
#pragma unroll 1
    for (int c = 0; c < NC; c += 3) {
        if (c + 2 < NC) AB_LOAD(c + 2, 2);
        AB_COMPUTE(c, 0);
        if (c + 3 < NC) AB_LOAD(c + 3, 0);
        if (c + 1 < NC) AB_COMPUTE(c + 1, 1);
        if (c + 4 < NC) AB_LOAD(c + 4, 1);
        if (c + 2 < NC) AB_COMPUTE(c + 2, 2);
    }
#undef AB_COMPUTE
#undef AB_LOAD
}
__device__ __forceinline__ void unit(int b, int slot, int q0, const bf16_t* QB, const bf16_t* KB, const bf16_t* VB, bf16_t* OB, LAS char* lds, int wid, int lane) {
    LAS char* vl = lds + wid * WAVE_LDS;
    const size_t seq0 = (size_t)b * SEQ * PB;
    const int fr = lane & 15, fq = lane >> 4;
    for (int rs = 0; rs < 2; ++rs) {
        const int t0r = q0 + wid + 8 * rs;
        float m_run = -1e30f, l_run = 0.f; f32x4 o[4];
#pragma unroll
        for (int dt = 0; dt < 4; ++dt) o[dt] = (f32x4){0.f, 0.f, 0.f, 0.f};
        group<1>(QB + seq0 + 0 * 256 + slot * 64, KB + seq0 + 0 * 256 + slot * 64, VB + seq0 + 0 * 256 + slot * 64, t0r, vl, lane, m_run, l_run, o);
        group<4>(QB + seq0 + 1 * 256 + slot * 64, KB + seq0 + 1 * 256 + slot * 64, VB + seq0 + 1 * 256 + slot * 64, t0r, vl, lane, m_run, l_run, o);
        group<16>(QB + seq0 + 2 * 256 + slot * 64, KB + seq0 + 2 * 256 + slot * 64, VB + seq0 + 2 * 256 + slot * 64, t0r, vl, lane, m_run, l_run, o);
        float l = l_run; l += __shfl_xor(l, 16); l += __shfl_xor(l, 32);
        const float il = __builtin_amdgcn_rcpf(l);
        bf16_t* op = OB + ((size_t)b * SEQ + t0r + 16 * fr) * 256 + slot * 64 + 4 * fq;
#pragma unroll
        for (int dt = 0; dt < 4; ++dt) { const f32x4 v = o[dt] * il; u32x2 w; w.x = pkbf(v[0], v[1]); w.y = pkbf(v[2], v[3]); *(u32x2*)(op + 16 * dt) = w; }
    }
}
}

#define RLX_AGENT __ATOMIC_RELAXED, __HIP_MEMORY_SCOPE_AGENT
#define XB_TMO      128
#define XB_XCNT(j)  (256  + 64 * (j))
#define XB_XSUB(j)  (1280 + 64 * (j))
#define XB_XGEN(j)  (2304 + 64 * (j))
#define XB_TOP      3328
#define XB_TOPGEN   3392
#define XCD_BAR_WORDS 3456
#define XB_SPIN_CAP (1u << 18)

__device__ __forceinline__ unsigned xb_ld(unsigned* p)              { return __hip_atomic_load(p, __ATOMIC_RELAXED, __HIP_MEMORY_SCOPE_AGENT); }
__device__ __forceinline__ unsigned xb_add(unsigned* p, unsigned v) { return __hip_atomic_fetch_add(p, v, __ATOMIC_RELAXED, __HIP_MEMORY_SCOPE_AGENT); }
__device__ __forceinline__ unsigned xb_xcc_id() { return (unsigned)__builtin_amdgcn_s_getreg((3 << 11) | 20) & 0xFu; }
#define XB_SPIN(cond, bar) do { unsigned _sp = 0; while (cond) { __builtin_amdgcn_s_sleep(1); \
    if ((++_sp & 255u) == 0u) { if (xb_ld(&(bar)[XB_TMO])) break; if (_sp > XB_SPIN_CAP) { atomicAdd(&(bar)[XB_TMO], 1u); break; } } } } while (0)

struct XcdBarrier {
    unsigned* bar; unsigned x;
    volatile LAS unsigned* st;
};

__device__ __forceinline__ XcdBarrier xcd_barrier_post(unsigned* bar, volatile LAS unsigned* st) {
    XcdBarrier b; b.bar = bar; b.x = xb_xcc_id(); b.st = st;
    if (threadIdx.x == 0) (void)xb_add(&bar[XB_XCNT(b.x)], 1u);
    return b;
}
__device__ __forceinline__ void xcd_barrier_complete(unsigned* bar, unsigned x, unsigned& nloc, unsigned& nx) {
    const unsigned G = gridDim.x * gridDim.y * gridDim.z;
    unsigned sum, cnt, mine, sp = 0u;
    for (;;) {
        sum = 0u; cnt = 0u; mine = 0u;
#pragma unroll
        for (unsigned j = 0; j < 16; ++j) { const unsigned c = xb_ld(&bar[XB_XCNT(j)]); sum += c; cnt += (c > 0u) ? 1u : 0u; mine = (j == x) ? c : mine; }
        if (sum == G) break;
        __builtin_amdgcn_s_sleep(1);
        if ((++sp & 255u) == 0u) { if (xb_ld(&bar[XB_TMO])) break; if (sp > XB_SPIN_CAP) { atomicAdd(&bar[XB_TMO], 1u); break; } }
    }
    nloc = mine > 0u ? mine : 1u; nx = cnt > 0u ? cnt : 1u;
}

__device__ __forceinline__ void xcd_barrier(const XcdBarrier& b) {
    asm volatile("s_waitcnt vmcnt(0)" ::: "memory");
    __syncthreads();
    if (threadIdx.x == 0) {
        unsigned* bar = b.bar;
        __builtin_amdgcn_s_waitcnt(0);
        unsigned nloc = b.st[0], nx = b.st[1];
        if (nloc == 0u) { xcd_barrier_complete(bar, b.x, nloc, nx); b.st[0] = nloc; b.st[1] = nx; }
        const unsigned old = xb_add(&bar[XB_XSUB(b.x)], 1u);
        const unsigned gen = old / nloc;
        if (old + 1u == (gen + 1u) * nloc) {
            __builtin_amdgcn_fence(__ATOMIC_RELEASE, "agent");
            asm volatile("s_waitcnt vmcnt(0)" ::: "memory");
            const unsigned og = xb_add(&bar[XB_TOP], 1u);
            const unsigned tg = og / nx;
            if (og + 1u == (tg + 1u) * nx) xb_add(&bar[XB_TOPGEN], 1u);
            else XB_SPIN(xb_ld(&bar[XB_TOPGEN]) == tg, bar);
            __builtin_amdgcn_fence(__ATOMIC_ACQUIRE, "agent");
            xb_add(&bar[XB_XGEN(b.x)], 1u);
            asm volatile("s_waitcnt vmcnt(0)" ::: "memory");
        } else {
            XB_SPIN(xb_ld(&bar[XB_XGEN(b.x)]) == gen, bar);
            __builtin_amdgcn_fence(__ATOMIC_ACQUIRE, "agent");
            asm volatile("s_waitcnt vmcnt(0)" ::: "memory");
        }
    }
    __syncthreads();
}

struct Args { const float* in[18]; float* out; unsigned char* ws; int ph_lo, ph_hi; };
constexpr int NPHASE = 1 + 9 * DEPTH;

__device__ __forceinline__ float wave_sum(float v) {
#pragma unroll
    for (int o = 1; o < 64; o <<= 1) v += __shfl_xor(v, o);
    return v;
}
__device__ __forceinline__ void tr_item(const float* __restrict__ W, int ldn, int k0, int n0, bf16_t* __restrict__ dst, int dld, int prow0, int dk0, int ncopy, int dkstride, LAS float* scr, int lane) {
#pragma unroll 8
    for (int i = 0; i < 32; ++i) { const int kk = 2 * i + (lane >> 5); scr[kk * 33 + (lane & 31)] = W[(size_t)(k0 + kk) * ldn + n0 + (lane & 31)]; }
    asm volatile("s_waitcnt lgkmcnt(0)" ::: "memory");
    const int c = lane & 7;
#pragma unroll
    for (int j = 0; j < 4; ++j) { const int n = (lane >> 3) + 8 * j; const LAS float* s = scr + (8 * c) * 33 + n;
        u32x4v o; o.x = pkbf(s[0 * 33], s[1 * 33]); o.y = pkbf(s[2 * 33], s[3 * 33]); o.z = pkbf(s[4 * 33], s[5 * 33]); o.w = pkbf(s[6 * 33], s[7 * 33]);
        for (int cp = 0; cp < ncopy; ++cp) *(u32x4v*)(dst + (size_t)(prow0 + n) * dld + dk0 + cp * dkstride + k0 + 8 * c) = o; }
    asm volatile("s_waitcnt lgkmcnt(0)" ::: "memory");
}

__global__ void __launch_bounds__(NWAVES * 64, 2) encoder_fwd(Args args) {
    extern __shared__ __attribute__((aligned(16))) unsigned char lds[];
    LAS unsigned char* L = (LAS unsigned char*)lds;
    const int G = gridDim.x, bx = blockIdx.x, vcu = (G % 8 == 0) ? (bx % 8) * (G / 8) + bx / 8 : bx;
    const int NGW = G * NWAVES;
    unsigned char* ws = args.ws;
    bf16_t* Wall = (bf16_t*)(ws + WS_W);
    bf16_t* H = (bf16_t*)(ws + WS_H); bf16_t* QA = (bf16_t*)(ws + WS_QA); unsigned char* BIG = ws + WS_BIG;
    bf16_t* KA = (bf16_t*)(BIG + BIG_KA); bf16_t* VA = (bf16_t*)(BIG + BIG_VA); bf16_t* QB = (bf16_t*)(BIG + BIG_QB); bf16_t* KB = (bf16_t*)(BIG + BIG_KB);
    bf16_t* VB = (bf16_t*)(BIG + BIG_VB); bf16_t* UC = (bf16_t*)(BIG + BIG_UC); bf16_t* GT = (bf16_t*)BIG; bf16_t* ACT = (bf16_t*)BIG;
    bf16_t* OB = (bf16_t*)(ws + WS_OB); bf16_t* PC = (bf16_t*)(ws + WS_PC);
    const float* xin = args.in[0]; float* xout = args.out;
    cg::grid_group grid = cg::this_grid();
    volatile LAS unsigned* bst = (volatile LAS unsigned*)(L + 131072 + 64);
    if (threadIdx.x < 2) bst[threadIdx.x] = 0u;
    __syncthreads();
    const XcdBarrier xbar = xcd_barrier_post((unsigned*)ws, bst);

    for (int ph = args.ph_lo; ph < args.ph_hi; ++ph) {
        int tid_raw = threadIdx.x; asm volatile("" : "+v"(tid_raw));
        const int tid = tid_raw, lane = tid & 63, wid = __builtin_amdgcn_readfirstlane(tid >> 6), gw = vcu * NWAVES + wid; (void)tid;
        if (ph == 0) {
            LAS float* scr = (LAS float*)(L + wid * 16384);
            constexpr int I_IN = 16 * 208, I_A = 8 * 32, I_B = 4 * 32, I_O = 16 * 32, I_G = 16 * 88, I_D = 44 * 32, NIT = I_IN + I_A + I_B + I_O + 2 * I_G + I_D;
            for (int it = gw; it < DEPTH * NIT; it += NGW) {
                const int l = it / NIT; int r = it % NIT; bf16_t* Wl = Wall + (size_t)l * W_LAYER;
                if (r < I_IN) { const int kb = r / 208, nb = r % 208; tr_item(args.in[2] + (size_t)l * 1024 * INW, INW, 64 * kb, 32 * nb, Wl + W_IN, 1024, finv(32 * nb), 0, 1, 0, scr, lane); continue; } r -= I_IN;
                if (r < I_A) { const int kb = r / 32, nb = r % 32; tr_item(args.in[10] + (size_t)l * 512 * 1024, 1024, 64 * kb, 32 * nb, Wl + W_A, 512, finv(32 * nb), 0, 1, 0, scr, lane); continue; } r -= I_A;
                if (r < I_B) { const int kb = r / 32, nb = r % 32; tr_item(args.in[11] + (size_t)l * 256 * 1024, 1024, 64 * kb, 32 * nb, Wl + W_B, 256, finv(32 * nb), 0, 1, 0, scr, lane); continue; } r -= I_B;
                if (r < I_O) { const int kb = r / 32, nb = r % 32; tr_item(args.in[13] + (size_t)l * 1024 * 1024, 1024, 64 * kb, 32 * nb, Wl + W_O3, 1024, finv(32 * nb), 0, 1, 0, scr, lane); continue; } r -= I_O;
                if (r < 2 * I_G) { const int up = r >= I_G; if (up) r -= I_G; const int kb = r / 88, nb = r % 88;
                    tr_item(args.in[up ? 16 : 15] + (size_t)l * 1024 * DFF, DFF, 64 * kb, 32 * nb, Wl + W_GU, 1024, finv(256 * (nb >> 2) + 64 * (nb & 3) + 32 * up), 0, 1, 0, scr, lane); continue; } r -= 2 * I_G;
                { const int kb = r / 32, nb = r % 32; tr_item(args.in[17] + (size_t)l * DFF * 1024, 1024, 64 * kb, 32 * nb, Wl + W_D, DFF, finv(32 * nb), 0, 1, 0, scr, lane); }
            }
            for (int it = gw; it < DEPTH * 64 * 16; it += NGW) {
                const int l = it / 1024, c8 = (it >> 4) & 63, nb = it & 15, g = c8 >> 4, n = 64 * nb + lane;
                const float* lin = args.in[8] + ((size_t)l * 4 + g) * 128 * 128 + (size_t)((8 * c8) & 127) * 128;
                const float* sc = args.in[9] + l * 512 + 128 * g;
                const float* wc = args.in[12] + ((size_t)l * 512 + 128 * g) * 1024 + n;
                float a[8];
#pragma unroll
                for (int cc = 0; cc < 8; ++cc) a[cc] = 0.f;
                for (int d = 0; d < 128; ++d) { const float w = wc[(size_t)d * 1024] * sc[d];
#pragma unroll
                    for (int cc = 0; cc < 8; ++cc) a[cc] += lin[cc * 128 + d] * w; }
                u32x4v o; o.x = pkbf(a[0], a[1]); o.y = pkbf(a[2], a[3]); o.z = pkbf(a[4], a[5]); o.w = pkbf(a[6], a[7]);
                *(u32x4v*)(Wall + (size_t)l * W_LAYER + W_C + (size_t)finv(n) * 512 + 8 * c8) = o;
            }
        } else {
            const int l = (ph - 1) / 9, sub = (ph - 1) % 9;
            const bf16_t* Wl = Wall + (size_t)l * W_LAYER;
            const float* xcur = (l == 0) ? xin : xout;
            if (sub == 0 || sub == 6) {
                const float* xs = (sub == 0) ? xcur : xout; const float* gn = args.in[sub == 0 ? 1 : 14] + l * DMODEL;
                f32x4 gv[4];
#pragma unroll
                for (int j = 0; j < 4; ++j) gv[j] = *((const f32x4*)gn + lane + 64 * j);
                for (int m = gw; m < MTOK; m += NGW) {
                    const f32x4* xr = (const f32x4*)(xs + (size_t)m * DMODEL) + lane; f32x4 v[4]; float s = 0.f;
#pragma unroll
                    for (int j = 0; j < 4; ++j) { v[j] = xr[64 * j]; s += (v[j][0] * v[j][0] + v[j][1] * v[j][1]) + (v[j][2] * v[j][2] + v[j][3] * v[j][3]); }
                    const float rs = __builtin_amdgcn_rsqf(wave_sum(s) * (1.f / DMODEL) + RMS_EPS);
                    u32x2* o8 = (u32x2*)(H + (size_t)m * DMODEL) + lane;
#pragma unroll
                    for (int j = 0; j < 4; ++j) { const f32x4 y = v[j] * rs * gv[j]; u32x2 w; w.x = pkbf(y[0], y[1]); w.y = pkbf(y[2], y[3]); o8[64 * j] = w; }
                }
            } else if (sub == 1) {
#ifndef SKIP1
                pg8::Gemm g{H, Wl + W_IN, MTOK, 3584, 1024}; pg8::StaticOrder S; S.init(MTOK, 3584, G, bx);
                pg8::EpiInProj1 E{QA, KA, VA, QB, KB, VB, UC, args.in[4] + l * 64, args.in[5] + l * 64, args.in[6] + l * 64, args.in[7] + l * 64};
                pg8::gemm_phase<pg8::EpiInProj1, pg8::StaticOrder, true, true>(L, g, S, E);
#endif
            } else if (sub == 2) {
#ifndef SKIP2A
                { const int per = (1024 + G - 1) / G;
                  for (int i = 0; i < per; ++i) { const int u = vcu * per + i; if (u >= 1024) break; const int bh = u >> 5, qb = u & 31, b = bh >> 3, h = bh & 7;
                      attn_body::attn_unit<8>(b, h, h >> 2, qb, (const attn_body::bf16*)QA, (const attn_body::bf16*)KA, (const attn_body::bf16*)VA, (attn_body::bf16*)QA, (char*)lds); } }
#endif
#ifndef SKIP2B
                { const int per = (512 + G - 1) / G;
                  for (int i = 0; i < per; ++i) { const int u = vcu * per + i; if (u >= 512) break; const int bs = u >> 5, qb = u & 31;
                      attnb::unit(bs >> 2, bs & 3, qb * 256, QB, KB, VB, OB, (LAS char*)L, wid, lane); } }
#endif
                for (int ch = gw; ch < MTOK / 16; ch += NGW) {
                    const int row0 = ch * 16, t0 = row0 & (SEQ - 1), hw = 1 << (lane >> 4);
                    const bf16_t* ub = UC + (size_t)(row0 - t0) * 512 + 8 * lane;
                    u32x4v u[31];
#pragma unroll
                    for (int i = 0; i < 31; ++i) { const int tt = t0 - 8 + i; const bool in = (tt >= 0) && (tt < SEQ); const u32x4v v = *(const u32x4v*)(ub + (size_t)(in ? tt : t0) * 512); u[i] = in ? v : (u32x4v){0u, 0u, 0u, 0u}; }
                    float mk[16];
#pragma unroll
                    for (int d = 0; d < 16; ++d) mk[d] = ((d - 8 >= -hw) && (d - 8 < hw)) ? 1.f : 0.f;
#pragma unroll
                    for (int jj = 0; jj < 16; ++jj) {
                        const int t = t0 + jj, lo = (t - hw < 0) ? 0 : t - hw, hi = (t + hw > SEQ) ? SEQ : t + hw; const float ic = 1.0f / (float)(hi - lo);
                        float sacc[8];
#pragma unroll
                        for (int k = 0; k < 8; ++k) sacc[k] = 0.f;
#pragma unroll
                        for (int d = 0; d < 16; ++d) { const u32x4v v = u[jj + d]; const float mm = mk[d];
                            sacc[0] += mm * bflo(v.x); sacc[1] += mm * bfhi(v.x); sacc[2] += mm * bflo(v.y); sacc[3] += mm * bfhi(v.y); sacc[4] += mm * bflo(v.z); sacc[5] += mm * bfhi(v.z); sacc[6] += mm * bflo(v.w); sacc[7] += mm * bfhi(v.w); }
                        const u32x4v sv = u[jj + 8]; u32x4v o;
                        o.x = pkbf(sacc[0] * ic - bflo(sv.x), sacc[1] * ic - bfhi(sv.x)); o.y = pkbf(sacc[2] * ic - bflo(sv.y), sacc[3] * ic - bfhi(sv.y));
                        o.z = pkbf(sacc[4] * ic - bflo(sv.z), sacc[5] * ic - bfhi(sv.z)); o.w = pkbf(sacc[6] * ic - bflo(sv.w), sacc[7] * ic - bfhi(sv.w));
                        *(u32x4v*)(PC + (size_t)(row0 + jj) * 512 + 8 * lane) = o;
                    }
                }
            } else if (sub == 3) {
                pg8::Gemm g{H, Wl + W_IN + (size_t)3584 * 1024, MTOK, GATEW, 1024}; pg8::StaticOrder S; S.init(MTOK, GATEW, G, bx);
                pg8::EpiGates E{GT, args.in[3] + l * GATEW};

#ifndef SKIP3
pg8::gemm_phase<pg8::EpiGates, pg8::StaticOrder, true, true>(L, g, S, E);
#endif

            } else if (sub == 4) {
                pg8::StaticOrder S; S.init(MTOK, DMODEL, G, bx);
#ifndef SKIP4
#pragma unroll 1
                for (int br = 0; br < 3; ++br) {
                    const bf16_t* Ab = (br == 0) ? QA : ((br == 1) ? OB : PC); const bf16_t* Bw = Wl + ((br == 0) ? W_A : ((br == 1) ? W_B : W_C));
                    pg8::Gemm g{Ab, Bw, MTOK, DMODEL, (br == 1) ? 256 : 512}; pg8::EpiMerge E{GT, H, 1024 * br, br == 0};
                    pg8::gemm_phase<pg8::EpiMerge, pg8::StaticOrder, true, true>(L, g, S, E);
                }
#endif
            } else if (sub == 5) {
                pg8::Gemm g{H, Wl + W_O3, MTOK, DMODEL, 1024}; pg8::StaticOrder S; S.init(MTOK, DMODEL, G, bx);

#ifndef SKIP5
pg8::EpiRes E{xcur, xout};
                pg8::gemm_phase<pg8::EpiRes, pg8::StaticOrder, true, true>(L, g, S, E);
#endif

            } else if (sub == 7) {
                pg8::Gemm g{H, Wl + W_GU, MTOK, 2 * DFF, 1024}; pg8::StaticOrder S; S.init(MTOK, 2 * DFF, G, bx);
                pg8::EpiFfn1 E{ACT};

#ifndef SKIP7
pg8::gemm_phase<pg8::EpiFfn1, pg8::StaticOrder, true, true>(L, g, S, E);
#endif

            } else {
                pg8::Gemm g{ACT, Wl + W_D, MTOK, DMODEL, DFF}; pg8::StaticOrder S; S.init(MTOK, DMODEL, G, bx);

#ifndef SKIP8
pg8::EpiRes E{xout, xout};
                pg8::gemm_phase<pg8::EpiRes, pg8::StaticOrder, true, true>(L, g, S, E);
#endif

            }
        }
        if (ph + 1 < args.ph_hi) { if (ph == args.ph_lo) grid.sync(); else xcd_barrier(xbar); }
    }
}

__global__ void dbg_dump(const unsigned short* src, float* out, size_t n) {
    for (size_t i = (size_t)blockIdx.x * blockDim.x + threadIdx.x; i < n; i += (size_t)gridDim.x * blockDim.x) out[i] = bf2f(src[i]);
}
#ifndef MK_ONE_LAUNCH
#define MK_ONE_LAUNCH 1
#endif
extern "C" void kernel_launch(void* const* d_in, const int* in_sizes, int n_in, void* d_out, int out_size, void* d_ws, size_t ws_size, hipStream_t stream) {
    static int grid = 0;
    if (grid == 0) {
        int dev = 0, cus = 0, per_cu = 0;
        if (n_in != 18 || out_size != MTOK * DMODEL || ws_size < WS_END) { fprintf(stderr, "kernel_launch: unexpected shapes (n_in %d out %d ws %zu)\n", n_in, out_size, ws_size); grid = -1; return; }
        if (hipGetDevice(&dev) != hipSuccess || hipDeviceGetAttribute(&cus, hipDeviceAttributeMultiprocessorCount, dev) != hipSuccess) { grid = -1; return; }
        if (hipFuncSetAttribute((const void*)encoder_fwd, hipFuncAttributeMaxDynamicSharedMemorySize, LDS_BYTES) != hipSuccess) { fprintf(stderr, "kernel_launch: hipFuncSetAttribute failed\n"); grid = -1; return; }
        if (hipOccupancyMaxActiveBlocksPerMultiprocessor(&per_cu, (const void*)encoder_fwd, NWAVES * 64, LDS_BYTES) != hipSuccess || per_cu < 1) per_cu = 1;
        (void)hipGetLastError();
        grid = cus * per_cu;
    }
    if (grid < 0) return;
    Args a{};
    for (int i = 0; i < 18; ++i) a.in[i] = (const float*)d_in[i];
    a.out = (float*)d_out; a.ws = (unsigned char*)d_ws;
#if MK_ONE_LAUNCH
    (void)hipMemsetAsync(d_ws, 0, 16384, stream);
    a.ph_lo = 0; a.ph_hi = NPHASE;
    void* kargs[] = {&a};
    hipError_t e = hipLaunchCooperativeKernel((const void*)encoder_fwd, dim3(grid), dim3(NWAVES * 64), kargs, LDS_BYTES, stream);
    if (e != hipSuccess) fprintf(stderr, "kernel_launch: cooperative launch failed: %s (grid %d)\n", hipGetErrorString(e), grid);
#else
#ifdef DBG_STOP
    for (int ph = 0; ph < DBG_STOP; ++ph) {
        a.ph_lo = ph; a.ph_hi = ph + 1;
        hipLaunchKernelGGL(encoder_fwd, dim3(grid), dim3(NWAVES * 64), LDS_BYTES, stream, a);
    }
    hipLaunchKernelGGL(dbg_dump, dim3(1024), dim3(256), 0, stream, (const unsigned short*)((unsigned char*)d_ws + DBG_OFF), (float*)d_out, (size_t)MTOK * DMODEL);
#else
    for (int ph = 0; ph < NPHASE; ++ph) {
        a.ph_lo = ph; a.ph_hi = ph + 1;
        hipLaunchKernelGGL(encoder_fwd, dim3(grid), dim3(NWAVES * 64), LDS_BYTES, stream, a);
    }
#endif
#endif
}
```
